# Optimizing an MI355X kernel written in HIP

```python
import jax, jax.numpy as jnp
from jax import lax
import numpy as np

D_MODEL = 1024
BATCH = 8
SEQ = 8192
DEPTH = 1

CTX_LEN = 256
GRID_W = 64
D_FF = 2816
N_MOD = 9
EPS = 1e-6
GDN_HEADS = D_MODEL // 128
GDN_HEAD_DIM = 128
GDN_WIDTH = GDN_HEADS * GDN_HEAD_DIM
CONV_K = 5
CHUNK = 64
POOL_WINDOWS = (2, 4, 8, 16)
POOL_GROUPS = len(POOL_WINDOWS)
POOL_WIDTH = D_MODEL // 2
POOL_GROUP_DIM = POOL_WIDTH // POOL_GROUPS
N_BRANCH = 2
QKV_END = 3 * GDN_WIDTH
AB_END = QKV_END + 4 * GDN_HEADS
GATE_END = AB_END + GDN_WIDTH
POOL_END = GATE_END + POOL_WIDTH
MIX_IN = POOL_END + N_BRANCH * D_MODEL

kernel_name = "hybrid_pool_gdn_macaron_dit"


def rmsnorm(x, w):
    xf = x.astype(jnp.float32)
    y = xf * lax.rsqrt(jnp.mean(xf * xf, axis=-1, keepdims=True) + EPS)
    return (y * w.astype(jnp.float32)).astype(x.dtype)


def modulate(n, shift, scale):
    return n * (1 + scale) + shift


def adaln(cvec, w, b):
    return jnp.split(jax.nn.silu(cvec) @ w + b, N_MOD, axis=-1)


def swiglu(h, w_in, w_out):
    g, u = jnp.split(h @ w_in, 2, axis=-1)
    return (jax.nn.silu(g) * u) @ w_out


def short_conv(x, w):
    pad = CONV_K // 2
    L = x.shape[1]
    xp = jnp.pad(x, ((0, 0), (pad, pad), (0, 0)))
    y = sum(xp[:, k:k + L] * w[k] for k in range(CONV_K))
    return jax.nn.silu(y)


def l2norm(x):
    return x * lax.rsqrt(jnp.sum(x * x, axis=-1, keepdims=True) + EPS)


def gdn_inputs(p, conv_w, a_log, dt_bias):
    B, L, _ = p.shape
    qkv = short_conv(p[..., :QKV_END], conv_w).astype(jnp.float32)
    q, k, v = [t.reshape(B, L, GDN_HEADS, GDN_HEAD_DIM) for t in jnp.split(qkv, 3, axis=-1)]
    q = l2norm(q) * GDN_HEAD_DIM ** -0.5
    k = l2norm(k)
    ab = p[..., QKV_END:AB_END].astype(jnp.float32).reshape(B, L, 4, GDN_HEADS)
    beta = jax.nn.sigmoid(ab[:, :, 0:2])
    g = -jnp.exp(a_log.astype(jnp.float32)) * jax.nn.softplus(ab[:, :, 2:4] + dt_bias.astype(jnp.float32))
    return q, k, v, beta, g


def _to_chunks(t, n):
    b, _, h = t.shape[:3]
    t = t.reshape((b, n, CHUNK, h) + t.shape[3:])
    return jnp.transpose(t, (1, 0, 3, 2) + tuple(range(4, t.ndim)))


def gated_delta(q, k, v, beta, g, S0):
    B, L, H, _ = q.shape
    dv = v.shape[-1]
    n = L // CHUNK
    qc, kc, vc = _to_chunks(q, n), _to_chunks(k, n), _to_chunks(v, n)
    bc, gc = _to_chunks(beta, n), _to_chunks(g, n)
    cum = jnp.cumsum(gc, axis=-1)
    idx = jnp.arange(CHUNK)
    incl = idx[:, None] >= idx[None, :]
    strict = idx[:, None] > idx[None, :]
    diff = cum[..., :, None] - cum[..., None, :]
    decay = jnp.where(incl, jnp.exp(jnp.where(incl, diff, 0.0)), 0.0)
    kb = kc * bc[..., None]
    vb = vc * bc[..., None]
    lmat = jnp.where(strict, jnp.einsum('nbhid,nbhjd->nbhij', kb, kc) * decay, 0.0)
    a_mat = lmat + jnp.eye(CHUNK, dtype=jnp.float32)
    rhs = jnp.concatenate([vb, kb * jnp.exp(cum)[..., None]], axis=-1)
    sol = lax.linalg.triangular_solve(a_mat, rhs, left_side=True, lower=True, unit_diagonal=True)
    u, w = sol[..., :dv], sol[..., dv:]
    aqk = jnp.einsum('nbhid,nbhjd->nbhij', qc, kc) * decay
    qd = qc * jnp.exp(cum)[..., None]
    kd = kc * jnp.exp(cum[..., -1:] - cum)[..., None]
    blast = jnp.exp(cum[..., -1])

    def step(S, xs):
        u_n, w_n, qd_n, kd_n, aqk_n, bl_n = xs
        v_new = u_n - jnp.einsum('bhcd,bhde->bhce', w_n, S)
        o = jnp.einsum('bhcd,bhde->bhce', qd_n, S) + jnp.einsum('bhij,bhje->bhie', aqk_n, v_new)
        S = S * bl_n[..., None, None] + jnp.einsum('bhcd,bhce->bhde', kd_n, v_new)
        return S, o

    S_fin, o = lax.scan(step, S0, (u, w, qd, kd, aqk, blast))
    o = jnp.transpose(o, (1, 0, 3, 2, 4)).reshape(B, L, H, dv)
    return o, S_fin


def bidir_gdn(lat, ctx):
    qx, kx, vx, bx, gx = lat
    qc, kc, vc, bcx, gcx = ctx
    B = qx.shape[0]
    S0 = jnp.zeros((B, GDN_HEADS, GDN_HEAD_DIM, GDN_HEAD_DIM), jnp.float32)
    fl = lambda t: jnp.flip(t, axis=1)
    oc_f, Sc_f = gated_delta(qc, kc, vc, bcx[:, :, 0], gcx[:, :, 0], S0)
    ox_f, _ = gated_delta(qx, kx, vx, bx[:, :, 0], gx[:, :, 0], Sc_f)
    oc_b, Sc_b = gated_delta(fl(qc), fl(kc), fl(vc), fl(bcx[:, :, 1]), fl(gcx[:, :, 1]), S0)
    ox_b, _ = gated_delta(fl(qx), fl(kx), fl(vx), fl(bx[:, :, 1]), fl(gx[:, :, 1]), Sc_b)
    return ox_f + fl(ox_b), oc_f + fl(oc_b)


def _bounds(n):
    t = jnp.arange(n)
    lo = jnp.stack([jnp.clip(t - w // 2, 0, n) for w in POOL_WINDOWS], axis=-1)
    hi = jnp.stack([jnp.clip(t + w - w // 2, 0, n) for w in POOL_WINDOWS], axis=-1)
    return lo, hi


def pool_grid(u):
    B, L, _ = u.shape
    R = L // GRID_W
    xg = u.astype(jnp.float32).reshape(B, R, GRID_W, POOL_GROUPS, POOL_GROUP_DIM)
    S = jnp.pad(jnp.cumsum(jnp.cumsum(xg, axis=1), axis=2), ((0, 0), (1, 0), (1, 0), (0, 0), (0, 0)))
    rlo, rhi = _bounds(R)
    clo, chi = _bounds(GRID_W)
    gi = jnp.arange(POOL_GROUPS)

    def corner(ri, ci):
        return S[:, ri[:, None, :], ci[None, :, :], gi[None, None, :], :]

    total = corner(rhi, chi) - corner(rlo, chi) - corner(rhi, clo) + corner(rlo, clo)
    area = ((rhi - rlo)[:, None, :] * (chi - clo)[None, :, :]).astype(jnp.float32)[..., None]
    return (total / area - xg).reshape(B, L, POOL_GROUPS, POOL_GROUP_DIM)


def pool_seq(u):
    B, L, _ = u.shape
    xg = u.astype(jnp.float32).reshape(B, L, POOL_GROUPS, POOL_GROUP_DIM)
    S = jnp.pad(jnp.cumsum(xg, axis=1), ((0, 0), (1, 0), (0, 0), (0, 0)))
    lo, hi = _bounds(L)
    gi = jnp.arange(POOL_GROUPS)[None, :]
    total = S[:, hi, gi, :] - S[:, lo, gi, :]
    count = (hi - lo).astype(jnp.float32)[..., None]
    return total / count - xg


def merge_branches(p, pool_diff, o, pool_w, pool_scale, gdn_norm_w, w_gdn_proj, w_pool_proj, w_mix_out):
    B, L, _ = p.shape
    dt = p.dtype
    gate = p[..., AB_END:GATE_END].reshape(B, L, GDN_HEADS, GDN_HEAD_DIM)
    o = rmsnorm(o.astype(dt), gdn_norm_w) * jax.nn.silu(gate)
    y_gdn = o.reshape(B, L, GDN_WIDTH) @ w_gdn_proj
    y_pool = jnp.einsum('blgc,gce->blge', pool_diff, pool_w.astype(jnp.float32)).reshape(B, L, POOL_WIDTH)
    y_pool = (y_pool * pool_scale.astype(jnp.float32)).astype(dt) @ w_pool_proj
    g_pool, g_gdn = jnp.split(jax.nn.sigmoid(p[..., POOL_END:]), N_BRANCH, axis=-1)
    return (g_pool * y_pool + g_gdn * y_gdn) @ w_mix_out


def setup_inputs(seed: int = 0) -> dict:
    key = jax.random.key(seed)
    ks = jax.random.split(key, 24)
    f32 = jnp.float32

    def nrm(k, shape, fan_in):
        return jax.random.normal(k, shape, f32) * fan_in ** -0.5

    def gain(k, shape):
        return 1.0 + 0.02 * jax.random.normal(k, shape, f32)

    dt = jnp.exp(jax.random.uniform(ks[12], (DEPTH, 2, GDN_HEADS), f32, np.log(1e-3), np.log(1e-1)))
    return {
        "x": jax.random.normal(ks[0], (BATCH, SEQ, D_MODEL), f32),
        "c": jax.random.normal(ks[1], (BATCH, D_MODEL), f32),
        "ctx": jax.random.normal(ks[2], (BATCH, CTX_LEN, D_MODEL), f32),
        "c_ctx": jax.random.normal(ks[3], (D_MODEL,), f32),
        "w_ada": nrm(ks[4], (DEPTH, D_MODEL, N_MOD * D_MODEL), D_MODEL),
        "b_ada": 0.02 * jax.random.normal(ks[5], (DEPTH, N_MOD * D_MODEL), f32),
        "norm1_w": gain(ks[6], (DEPTH, D_MODEL)),
        "ffn1_w_in": nrm(ks[7], (DEPTH, D_MODEL, 2 * D_FF), D_MODEL),
        "ffn1_w_out": nrm(ks[8], (DEPTH, D_FF, D_MODEL), D_FF),
        "norm2_w": gain(ks[9], (DEPTH, D_MODEL)),
        "w_mix_in": nrm(ks[10], (DEPTH, D_MODEL, MIX_IN), D_MODEL),
        "conv_w": nrm(ks[11], (DEPTH, CONV_K, QKV_END), CONV_K),
        "a_log": jnp.log(jax.random.uniform(ks[13], (DEPTH, 2, GDN_HEADS), f32, 1.0, 16.0)),
        "dt_bias": dt + jnp.log(-jnp.expm1(-dt)),
        "gdn_norm_w": gain(ks[14], (DEPTH, GDN_HEAD_DIM)),
        "w_gdn_proj": nrm(ks[15], (DEPTH, GDN_WIDTH, D_MODEL), GDN_WIDTH),
        "pool_w": nrm(ks[16], (DEPTH, POOL_GROUPS, POOL_GROUP_DIM, POOL_GROUP_DIM), POOL_GROUP_DIM),
        "pool_scale": gain(ks[17], (DEPTH, POOL_WIDTH)),
        "w_pool_proj": nrm(ks[18], (DEPTH, POOL_WIDTH, D_MODEL), POOL_WIDTH),
        "w_mix_out": nrm(ks[19], (DEPTH, D_MODEL, D_MODEL), D_MODEL),
        "norm3_w": gain(ks[20], (DEPTH, D_MODEL)),
        "ffn2_w_in": nrm(ks[21], (DEPTH, D_MODEL, 2 * D_FF), D_MODEL),
        "ffn2_w_out": nrm(ks[22], (DEPTH, D_FF, D_MODEL), D_FF),
        "final_norm_w": gain(ks[23], (D_MODEL,)),
    }


def reference(x, c, ctx, c_ctx, w_ada, b_ada, norm1_w, ffn1_w_in, ffn1_w_out, norm2_w, w_mix_in,
              conv_w, a_log, dt_bias, gdn_norm_w, w_gdn_proj, pool_w, pool_scale, w_pool_proj,
              w_mix_out, norm3_w, ffn2_w_in, ffn2_w_out, final_norm_w):
    for i in range(DEPTH):
        last = i == DEPTH - 1
        mx = [m[:, None, :] for m in adaln(c, w_ada[i], b_ada[i])]
        mc = adaln(c_ctx, w_ada[i], b_ada[i])

        x = x + 0.5 * mx[2] * swiglu(modulate(rmsnorm(x, norm1_w[i]), mx[0], mx[1]), ffn1_w_in[i], ffn1_w_out[i])
        ctx = ctx + 0.5 * mc[2] * swiglu(modulate(rmsnorm(ctx, norm1_w[i]), mc[0], mc[1]), ffn1_w_in[i], ffn1_w_out[i])

        ux = modulate(rmsnorm(x, norm2_w[i]), mx[3], mx[4])
        uc = modulate(rmsnorm(ctx, norm2_w[i]), mc[3], mc[4])
        px = ux @ w_mix_in[i]
        pc = uc @ (w_mix_in[i][:, :AB_END] if last else w_mix_in[i])
        lat_in = gdn_inputs(px[..., :AB_END], conv_w[i], a_log[i], dt_bias[i])
        ctx_in = gdn_inputs(pc[..., :AB_END], conv_w[i], a_log[i], dt_bias[i])
        ox, oc = bidir_gdn(lat_in, ctx_in)
        mix_x = merge_branches(px, pool_grid(px[..., GATE_END:POOL_END]), ox, pool_w[i], pool_scale[i],
                               gdn_norm_w[i], w_gdn_proj[i], w_pool_proj[i], w_mix_out[i])
        x = x + mx[5] * mix_x

        x = x + 0.5 * mx[8] * swiglu(modulate(rmsnorm(x, norm3_w[i]), mx[6], mx[7]), ffn2_w_in[i], ffn2_w_out[i])

        if not last:
            mix_c = merge_branches(pc, pool_seq(pc[..., GATE_END:POOL_END]), oc, pool_w[i], pool_scale[i],
                                   gdn_norm_w[i], w_gdn_proj[i], w_pool_proj[i], w_mix_out[i])
            ctx = ctx + mc[5] * mix_c
            ctx = ctx + 0.5 * mc[8] * swiglu(modulate(rmsnorm(ctx, norm3_w[i]), mc[6], mc[7]), ffn2_w_in[i], ffn2_w_out[i])
    return rmsnorm(x, final_norm_w)
```

```cpp
#include <hip/hip_runtime.h>
#include <hip/hip_cooperative_groups.h>
#include <cstdio>
namespace cg = cooperative_groups;

#define LAS __attribute__((address_space(3)))
typedef unsigned short bf16_t;
typedef short bf16x8 __attribute__((ext_vector_type(8)));
typedef float f32x4 __attribute__((ext_vector_type(4)));
typedef unsigned u32x4 __attribute__((ext_vector_type(4)));
typedef unsigned u32x2 __attribute__((ext_vector_type(2)));

constexpr int D = 1024, ML = 65536, MC = 2048, MT = ML + MC, DFF = 2816, NMIX = 6912, NMOD = 9216;
constexpr size_t MiB = (size_t)1 << 20;
constexpr size_t WS_X1 = 0, WS_QKV = 132 * MiB, WS_GATE = 528 * MiB, WS_POOL = 656 * MiB, WS_MIXG = 720 * MiB, WS_BG = 976 * MiB,
                 WS_WTGDN = 985 * MiB, WS_WTPOOL = 987 * MiB, WS_WTMIXOUT = 988 * MiB, WS_WTFFN2IN = 990 * MiB, WS_WTFFN2OUT = 1001 * MiB,
                 WS_MODS = 1007 * MiB, WS_WTPOOLW = 1007 * MiB + 512 * 1024, WS_BAR = 1007 * MiB + 768 * 1024, WS_TOTAL = 1008 * MiB;
constexpr size_t WS_HID = WS_QKV, WS_T = WS_QKV, WS_M = WS_QKV + 128 * MiB, WS_POOLPRE = WS_QKV + 256 * MiB, WS_H3 = WS_GATE;
constexpr size_t DO_H = 0, DO_WTFFN1IN = 132 * MiB, DO_WTFFN1OUT = 143 * MiB, DO_SIDE = 149 * MiB, DO_WTMIX = 174 * MiB, DO_OF = 0, DO_OB = 128 * MiB;
constexpr size_t kDynLds = 163840;

struct Params {
    const float *x, *c, *ctx, *c_ctx, *w_ada, *b_ada, *norm1_w, *ffn1_w_in, *ffn1_w_out, *norm2_w, *w_mix_in, *conv_w, *a_log, *dt_bias,
        *gdn_norm_w, *w_gdn_proj, *pool_w, *pool_scale, *w_pool_proj, *w_mix_out, *norm3_w, *ffn2_w_in, *ffn2_w_out, *final_norm_w;
    float* out;
    unsigned char* ws;
};

typedef __bf16 bf16x2_t __attribute__((ext_vector_type(2)));
typedef float f32x2_t __attribute__((ext_vector_type(2)));
__device__ __forceinline__ unsigned cvt_pk_bf16(float lo, float hi) { f32x2_t v = {lo, hi}; bf16x2_t r = __builtin_convertvector(v, bf16x2_t); return __builtin_bit_cast(unsigned, r); }
__device__ __forceinline__ bf16_t f2bf(float f) { return (bf16_t)(cvt_pk_bf16(f, 0.f) & 0xffffu); }
__device__ __forceinline__ float bf2f(bf16_t b) { return __uint_as_float(((unsigned)b) << 16); }
__device__ __forceinline__ float bflo(unsigned u) { return __uint_as_float(u << 16); }
__device__ __forceinline__ float bfhi(unsigned u) { return __uint_as_float(u & 0xffff0000u); }
__device__ __forceinline__ float sigmoid_f(float x) { return __builtin_amdgcn_rcpf(1.f + __builtin_amdgcn_exp2f(-1.4426950408889634f * x)); }
__device__ __forceinline__ float silu_f(float x) { return x * sigmoid_f(x); }
__device__ __forceinline__ float softplus_f(float x) { return x > 20.f ? x : log1pf(__expf(x)); }
__device__ __forceinline__ float wave_sum(float v) {
#pragma unroll
    for (int o = 32; o >= 1; o >>= 1) v += __shfl_xor(v, o);
    return v;
}

namespace pg8 {
constexpr int BM = 256, BK = 64, HALF = 128, HTB = HALF * BK * 2, STAGE_BYTES = 8 * HTB, NXCD = 8, WGM = 8;
__device__ __forceinline__ int lds_byte(int r, int c) { const int st = (r >> 4) * 2 + (c >> 5), rr = r & 15, cc = c & 31, ob = rr * 64 + cc * 2; return st * 1024 + (ob ^ (((ob >> 9) & 1) << 5)); }
__device__ __forceinline__ void stage_rc(int b, int& R, int& C) { const int st = b / 1024, sb = b % 1024, swz = sb ^ (((sb >> 9) & 1) << 5); R = (st >> 1) * 16 + swz / 64; C = (st & 1) * 32 + (swz % 64) / 2; }
__device__ __forceinline__ int perm32(int rho) { const int n = rho >> 4, i = rho & 15; return 8 * (i >> 2) + 4 * n + (i & 3); }
struct Unit { int pm, pn; };
struct Gemm { const bf16_t* A; const bf16_t* Bt; int M, N, K; };
struct StaticOrder {
    int nM, nN, nwg, G, c;
    __device__ void init(int M, int N, int G_, int c_) { nM = M / BM; nN = N / BM; nwg = nM * nN; G = G_; c = c_; }
    __device__ bool next(int i, Unit& u) const {
        const long L = (long)i * G + c; if (L >= nwg) return false;
        int wgid = (int)L; { const int q = nwg / NXCD, r = nwg % NXCD, xcd = wgid % NXCD, off = wgid / NXCD; wgid = (xcd < r ? xcd * (q + 1) : r * (q + 1) + (xcd - r) * q) + off; }
        const int nig = WGM * nN, gid = wgid / nig, fm = gid * WGM, gsz = (nM - fm) < WGM ? (nM - fm) : WGM;
        u.pm = fm + ((wgid % nig) % gsz); u.pn = (wgid % nig) / gsz; return true;
    }
};

template <class Epi>
__device__ __forceinline__ void gemm_phase(LAS unsigned char* lds, const Gemm g, const StaticOrder& S, const Epi& E) {
    int tid_ = threadIdx.x; asm volatile("" : "+v"(tid_));
    const int tid = tid_, wid = __builtin_amdgcn_readfirstlane(tid >> 6), lane = tid & 63, wr = wid >> 2, wc = wid & 3, fr = lane & 15, fq = lane >> 4;
    const int K = g.K, nt = K / BK;
    unsigned voffA[2], voffB[2];
#pragma unroll
    for (int i = 0; i < 2; ++i) { int R, C; stage_rc(tid * 16 + i * 8192, R, C); const int Rb = Epi::PERM ? ((R & ~31) + perm32(R & 31)) : R;
        voffA[i] = (unsigned)(R * K + C) * 2u; voffB[i] = (unsigned)(Rb * K + C) * 2u; }
    const size_t kstep = (size_t)(BK * 2);
    const size_t hstep = (size_t)HALF * K * 2;
    const size_t tstep = 2 * hstep;
    const unsigned ldsw = (unsigned)wid * 1024u;
    const int aoff = lds_byte(wr * 64 + fr, fq * 8), boff = lds_byte(wc * 32 + fr, fq * 8);
#define PG8_SA(b, h) (((b) * 2 + (h)) * HTB)
#define PG8_SB(b, h) ((4 + (b) * 2 + (h)) * HTB)
#define PG8_STAGE(bufoff, gbase, voff) do { _Pragma("unroll") for (int _i = 0; _i < 2; ++_i) \
        __builtin_amdgcn_global_load_lds((const unsigned*)((const char*)(gbase) + (voff)[_i]), (LAS unsigned*)(lds + (bufoff) + ldsw + _i * 8192), 16, 0, 0); } while (0)
#define PG8_LDA(dst, b, h) do { _Pragma("unroll") for (int m = 0; m < 4; ++m) _Pragma("unroll") for (int k = 0; k < 2; ++k) dst[m][k] = *(const LAS bf16x8*)(lds + PG8_SA(b, h) + aoff + m * 2048 + k * 1024); } while (0)
#define PG8_LDB(dst, b, h) do { _Pragma("unroll") for (int n = 0; n < 2; ++n) _Pragma("unroll") for (int k = 0; k < 2; ++k) dst[n][k] = *(const LAS bf16x8*)(lds + PG8_SB(b, h) + boff + n * 2048 + k * 1024); } while (0)
#define PG8_MMA(ai, bj, At, Bt) do { __builtin_amdgcn_s_setprio(1); _Pragma("unroll") for (int m = 0; m < 4; ++m) _Pragma("unroll") for (int n = 0; n < 2; ++n) _Pragma("unroll") for (int k = 0; k < 2; ++k) \
        acc[ai][bj][m][n] = __builtin_amdgcn_mfma_f32_16x16x32_bf16(Bt[n][k], At[m][k], acc[ai][bj][m][n], 0, 0, 0); __builtin_amdgcn_s_setprio(0); } while (0)
#define PG8_WAIT_V(n) asm volatile("s_waitcnt vmcnt(" #n ")" ::: "memory")
#define PG8_WAIT_L(n) asm volatile("s_waitcnt lgkmcnt(" #n ")" ::: "memory")
#define PG8_BAR __builtin_amdgcn_s_barrier()
#define PG8_SCHED __builtin_amdgcn_sched_barrier(0)
    Unit cur, nxt; int ui = 0;
    if (!S.next(0, cur)) return;
    f32x4 acc[2][2][4][2];
#pragma unroll
    for (int a = 0; a < 2; ++a)
#pragma unroll
        for (int b = 0; b < 2; ++b)
#pragma unroll
            for (int m = 0; m < 4; ++m)
#pragma unroll
                for (int n = 0; n < 2; ++n) acc[a][b][m][n] = (f32x4){0.f, 0.f, 0.f, 0.f};
    bf16x8 At[4][2], B0[2][2], B1[2][2];
    const char* cA = (const char*)g.A + (size_t)cur.pm * tstep; const char* cB = (const char*)g.Bt + (size_t)cur.pn * tstep;
    PG8_STAGE(PG8_SB(0, 0), cB, voffB); PG8_STAGE(PG8_SA(0, 0), cA, voffA); PG8_STAGE(PG8_SB(0, 1), cB + hstep, voffB); PG8_STAGE(PG8_SA(0, 1), cA + hstep, voffA);
    if (wr == 1) PG8_BAR;
    PG8_WAIT_V(4); PG8_BAR;
    PG8_STAGE(PG8_SB(1, 0), cB + kstep, voffB); PG8_STAGE(PG8_SA(1, 0), cA + kstep, voffA); PG8_STAGE(PG8_SB(1, 1), cB + hstep + kstep, voffB);
    PG8_WAIT_V(6); PG8_BAR;
    for (;;) {
        const bool has_next = S.next(ui + 1, nxt);
        const char* nA = has_next ? (const char*)g.A + (size_t)nxt.pm * tstep : cA; const char* nB = has_next ? (const char*)g.Bt + (size_t)nxt.pn * tstep : cB;
        for (int t = 0; t < nt; t += 2) {
            const bool last = (t == nt - 2);
            const char* a1 = cA + (size_t)(t + 1) * kstep;
            const char* a2 = last ? nA : cA + (size_t)(t + 2) * kstep; const char* b2 = last ? nB : cB + (size_t)(t + 2) * kstep;
            const char* a3 = a2 + kstep; const char* b3 = b2 + kstep;
            PG8_LDB(B0, 0, 0); PG8_SCHED; PG8_LDA(At, 0, 0); PG8_STAGE(PG8_SA(1, 1), a1 + hstep, voffA);
            PG8_WAIT_L(8); PG8_BAR; PG8_WAIT_L(0); PG8_MMA(0, 0, At, B0); PG8_BAR; PG8_SCHED;
            PG8_LDB(B1, 0, 1); PG8_STAGE(PG8_SB(0, 0), b2, voffB);
            PG8_BAR; PG8_WAIT_L(0); PG8_MMA(0, 1, At, B1); PG8_BAR;
            PG8_LDA(At, 0, 1); PG8_STAGE(PG8_SA(0, 0), a2, voffA);
            PG8_BAR; PG8_WAIT_L(0); PG8_MMA(1, 0, At, B0); PG8_BAR; PG8_SCHED;
            PG8_STAGE(PG8_SB(0, 1), b2 + hstep, voffB);
            PG8_WAIT_V(6); PG8_BAR; PG8_MMA(1, 1, At, B1); PG8_BAR;
            PG8_LDB(B0, 1, 0); PG8_SCHED; PG8_LDA(At, 1, 0); PG8_STAGE(PG8_SA(0, 1), a2 + hstep, voffA);
            PG8_WAIT_L(8); PG8_BAR; PG8_WAIT_L(0); PG8_MMA(0, 0, At, B0); PG8_BAR; PG8_SCHED;
            PG8_LDB(B1, 1, 1); PG8_STAGE(PG8_SB(1, 0), b3, voffB);
            PG8_BAR; PG8_WAIT_L(0); PG8_MMA(0, 1, At, B1); PG8_BAR;
            PG8_LDA(At, 1, 1); PG8_STAGE(PG8_SA(1, 0), a3, voffA);
            PG8_BAR; PG8_WAIT_L(0); PG8_MMA(1, 0, At, B0); PG8_BAR; PG8_SCHED;
            PG8_STAGE(PG8_SB(1, 1), b3 + hstep, voffB);
            PG8_WAIT_V(6); PG8_BAR; PG8_MMA(1, 1, At, B1); PG8_BAR;
        }
        E(acc, cur, wr, wc, fr, fq);
        if (!has_next) break;
#pragma unroll
        for (int a = 0; a < 2; ++a)
#pragma unroll
            for (int b = 0; b < 2; ++b)
#pragma unroll
                for (int m = 0; m < 4; ++m)
#pragma unroll
                    for (int n = 0; n < 2; ++n) acc[a][b][m][n] = (f32x4){0.f, 0.f, 0.f, 0.f};
        cur = nxt; cA = nA; cB = nB; ++ui;
    }
    PG8_WAIT_V(0);
    if (wr == 0) PG8_BAR;
    PG8_BAR;
#undef PG8_SA
#undef PG8_SB
#undef PG8_STAGE
#undef PG8_LDA
#undef PG8_LDB
#undef PG8_MMA
#undef PG8_WAIT_V
#undef PG8_WAIT_L
#undef PG8_BAR
#undef PG8_SCHED
}
}
using pg8::Unit;

struct EpiFfnA {
    static constexpr bool PERM = true;
    bf16_t* H;
    __device__ __forceinline__ void operator()(const f32x4 (&acc)[2][2][4][2], const Unit& u, int wr, int wc, int fr, int fq) const {
        const int row0 = u.pm * 256 + wr * 64 + fr, col0 = u.pn * 128 + wc * 32 + 8 * fq;
#pragma unroll
        for (int ai = 0; ai < 2; ++ai)
#pragma unroll
            for (int m = 0; m < 4; ++m) {
                bf16_t* rowp = H + (size_t)(row0 + ai * 128 + m * 16) * DFF + col0;
                const f32x4 g0 = acc[ai][0][m][0], g1 = acc[ai][0][m][1], u0 = acc[ai][1][m][0], u1 = acc[ai][1][m][1];
                u32x4 o;
                o[0] = cvt_pk_bf16(silu_f(g0[0]) * u0[0], silu_f(g0[1]) * u0[1]); o[1] = cvt_pk_bf16(silu_f(g0[2]) * u0[2], silu_f(g0[3]) * u0[3]);
                o[2] = cvt_pk_bf16(silu_f(g1[0]) * u1[0], silu_f(g1[1]) * u1[1]); o[3] = cvt_pk_bf16(silu_f(g1[2]) * u1[2], silu_f(g1[3]) * u1[3]);
                *(u32x4*)rowp = o;
            }
    }
};
template <bool FIRST> struct EpiFfnB {
    static constexpr bool PERM = false;
    const float* x; const float* ctx; bf16_t* X1; float* out; const float* mods; int gate_i; int pm_off;
    __device__ __forceinline__ void operator()(const f32x4 (&acc)[2][2][4][2], const Unit& u, int wr, int wc, int fr, int fq) const {
        const int pmg = u.pm + pm_off;
        const int row0 = pmg * 256 + wr * 64 + fr, col0 = u.pn * 256 + wc * 32 + 4 * fq;
        const int b = pmg < 256 ? (pmg >> 5) : 8;
        f32x4 gv[2][2];
#pragma unroll
        for (int bj = 0; bj < 2; ++bj)
#pragma unroll
            for (int n = 0; n < 2; ++n) gv[bj][n] = 0.5f * *(const f32x4*)(mods + (size_t)b * NMOD + gate_i * 1024 + col0 + bj * 128 + n * 16);
#pragma unroll
        for (int ai = 0; ai < 2; ++ai)
#pragma unroll
            for (int m = 0; m < 4; ++m) {
                const int row = row0 + ai * 128 + m * 16;
                if (FIRST) {
                    const float* srow = (row < ML ? x + (size_t)row * D : ctx + (size_t)(row - ML) * D) + col0;
                    bf16_t* orow = X1 + (size_t)row * D + col0;
#pragma unroll
                    for (int bj = 0; bj < 2; ++bj)
#pragma unroll
                        for (int n = 0; n < 2; ++n) {
                            const f32x4 s = *(const f32x4*)(srow + bj * 128 + n * 16); const f32x4 r = s + gv[bj][n] * acc[ai][bj][m][n];
                            u32x2 o; o[0] = cvt_pk_bf16(r[0], r[1]); o[1] = cvt_pk_bf16(r[2], r[3]); *(u32x2*)(orow + bj * 128 + n * 16) = o;
                        }
                } else {
                    float* prow = out + (size_t)row * D + col0;
#pragma unroll
                    for (int bj = 0; bj < 2; ++bj)
#pragma unroll
                        for (int n = 0; n < 2; ++n) { f32x4* q = (f32x4*)(prow + bj * 128 + n * 16); *q = *q + gv[bj][n] * acc[ai][bj][m][n]; }
                }
            }
    }
};
template <int KIND>
__device__ __forceinline__ void store_act(const f32x4 (&acc)[2][2][4][2], bf16_t* dst, int ld, int cbase, int row0, int wc, int fq) {
#pragma unroll
    for (int ai = 0; ai < 2; ++ai)
#pragma unroll
        for (int m = 0; m < 4; ++m) {
            const int row = row0 + ai * 128 + m * 16;
#pragma unroll
            for (int bj = 0; bj < 2; ++bj) {
                const int col = cbase + bj * 128 + wc * 32 + 8 * fq;
                f32x4 v0 = acc[ai][bj][m][0], v1 = acc[ai][bj][m][1];
                if (KIND == 0) {
#pragma unroll
                    for (int j = 0; j < 4; ++j) { v0[j] = silu_f(v0[j]); v1[j] = silu_f(v1[j]); }
                } else if (KIND == 2) {
#pragma unroll
                    for (int j = 0; j < 4; ++j) { v0[j] = sigmoid_f(v0[j]); v1[j] = sigmoid_f(v1[j]); }
                }
                u32x4 o; o[0] = cvt_pk_bf16(v0[0], v0[1]); o[1] = cvt_pk_bf16(v0[2], v0[3]); o[2] = cvt_pk_bf16(v1[0], v1[1]); o[3] = cvt_pk_bf16(v1[2], v1[3]);
                *(u32x4*)(dst + (size_t)row * ld + col) = o;
            }
        }
}
struct EpiMix {
    static constexpr bool PERM = true;
    bf16_t *QKV, *SIDE, *GATE, *POOL, *MIXG; float* BG; const float* a_log; const float* dt_bias;
    __device__ __forceinline__ void operator()(const f32x4 (&acc)[2][2][4][2], const Unit& u, int wr, int wc, int fr, int fq) const {
        const int pn = u.pn, row0 = u.pm * 256 + wr * 64 + fr; const bool lat = u.pm < 256;
        if (pn < 12) {
#pragma unroll
            for (int ai = 0; ai < 2; ++ai)
#pragma unroll
                for (int m = 0; m < 4; ++m) {
                    const int row = row0 + ai * 128 + m * 16;
#pragma unroll
                    for (int bj = 0; bj < 2; ++bj) {
                        const int col = pn * 256 + bj * 128 + wc * 32 + 8 * fq;
                        const f32x4 v0 = acc[ai][bj][m][0], v1 = acc[ai][bj][m][1];
                        u32x4 o; o[0] = cvt_pk_bf16(v0[0], v0[1]); o[1] = cvt_pk_bf16(v0[2], v0[3]); o[2] = cvt_pk_bf16(v1[0], v1[1]); o[3] = cvt_pk_bf16(v1[2], v1[3]);
                        *(u32x4*)(QKV + (size_t)row * 3072 + col) = o;
                        if ((m == 0 && fr < 2) || (m == 3 && fr >= 14)) {
                            const int slot = (m == 0) ? fr : fr - 12; const int tile = row >> 6;
                            *(u32x4*)(SIDE + ((size_t)tile * 4 + slot) * 3072 + col) = o;
                        }
                    }
                }
        } else if (pn < 16) {
            if (!lat) return;
            store_act<0>(acc, GATE, 1024, (pn - 12) * 256, row0, wc, fq);
        } else if (pn < 18) {
            if (!lat) return;
            store_act<1>(acc, POOL, 512, (pn - 16) * 256, row0, wc, fq);
        } else if (pn < 26) {
            if (!lat) return;
            store_act<2>(acc, MIXG, 2048, (pn - 18) * 256, row0, wc, fq);
        } else {
            if (wc != 0) return;
            float al[8], db[8]; bool isg = fq >= 2;
#pragma unroll
            for (int j = 0; j < 8; ++j) { const int idx = (8 * fq + j) & 15; al[j] = __expf(a_log[idx]); db[j] = dt_bias[idx]; }
#pragma unroll
            for (int ai = 0; ai < 2; ++ai)
#pragma unroll
                for (int m = 0; m < 4; ++m) {
                    const int row = row0 + ai * 128 + m * 16;
                    f32x4 r[2];
#pragma unroll
                    for (int n = 0; n < 2; ++n)
#pragma unroll
                        for (int j = 0; j < 4; ++j) {
                            const float v = acc[ai][0][m][n][j];
                            r[n][j] = isg ? -al[4 * n + j] * softplus_f(v + db[4 * n + j]) : sigmoid_f(v);
                        }
                    float* bp = BG + (size_t)row * 32 + 8 * fq;
                    *(f32x4*)bp = r[0]; *(f32x4*)(bp + 4) = r[1];
                }
        }
    }
};
template <int MODE> struct EpiMerge {
    static constexpr bool PERM = true;
    const bf16_t* MIXG; const bf16_t* Tin; bf16_t* O;
    __device__ __forceinline__ void operator()(const f32x4 (&acc)[2][2][4][2], const Unit& u, int wr, int wc, int fr, int fq) const {
        const int row0 = u.pm * 256 + wr * 64 + fr;
#pragma unroll
        for (int ai = 0; ai < 2; ++ai)
#pragma unroll
            for (int m = 0; m < 4; ++m) {
                const int row = row0 + ai * 128 + m * 16;
#pragma unroll
                for (int bj = 0; bj < 2; ++bj) {
                    const int col = u.pn * 256 + bj * 128 + wc * 32 + 8 * fq;
                    const u32x4 gq = *(const u32x4*)(MIXG + (size_t)row * 2048 + (MODE ? 1024 : 0) + col);
                    const f32x4 v0 = acc[ai][bj][m][0], v1 = acc[ai][bj][m][1];
                    float r[8];
                    r[0] = bflo(gq[0]) * v0[0]; r[1] = bfhi(gq[0]) * v0[1]; r[2] = bflo(gq[1]) * v0[2]; r[3] = bfhi(gq[1]) * v0[3];
                    r[4] = bflo(gq[2]) * v1[0]; r[5] = bfhi(gq[2]) * v1[1]; r[6] = bflo(gq[3]) * v1[2]; r[7] = bfhi(gq[3]) * v1[3];
                    if (MODE) {
                        const u32x4 tq = *(const u32x4*)(Tin + (size_t)row * D + col);
                        r[0] += bflo(tq[0]); r[1] += bfhi(tq[0]); r[2] += bflo(tq[1]); r[3] += bfhi(tq[1]);
                        r[4] += bflo(tq[2]); r[5] += bfhi(tq[2]); r[6] += bflo(tq[3]); r[7] += bfhi(tq[3]);
                    }
                    u32x4 o; o[0] = cvt_pk_bf16(r[0], r[1]); o[1] = cvt_pk_bf16(r[2], r[3]); o[2] = cvt_pk_bf16(r[4], r[5]); o[3] = cvt_pk_bf16(r[6], r[7]);
                    *(u32x4*)(O + (size_t)row * D + col) = o;
                }
            }
    }
};
struct EpiMixOut {
    static constexpr bool PERM = false;
    const bf16_t* X1; float* out; const float* mods;
    __device__ __forceinline__ void operator()(const f32x4 (&acc)[2][2][4][2], const Unit& u, int wr, int wc, int fr, int fq) const {
        const int row0 = u.pm * 256 + wr * 64 + fr, col0 = u.pn * 256 + wc * 32 + 4 * fq;
        const int b = u.pm >> 5;
        f32x4 gv[2][2];
#pragma unroll
        for (int bj = 0; bj < 2; ++bj)
#pragma unroll
            for (int n = 0; n < 2; ++n) gv[bj][n] = *(const f32x4*)(mods + (size_t)b * NMOD + 5 * 1024 + col0 + bj * 128 + n * 16);
#pragma unroll
        for (int ai = 0; ai < 2; ++ai)
#pragma unroll
            for (int m = 0; m < 4; ++m) {
                const int row = row0 + ai * 128 + m * 16;
#pragma unroll
                for (int bj = 0; bj < 2; ++bj)
#pragma unroll
                    for (int n = 0; n < 2; ++n) {
                        const int col = col0 + bj * 128 + n * 16;
                        const u32x2 xq = *(const u32x2*)(X1 + (size_t)row * D + col);
                        f32x4 r; r[0] = bflo(xq[0]); r[1] = bfhi(xq[0]); r[2] = bflo(xq[1]); r[3] = bfhi(xq[1]);
                        r = r + gv[bj][n] * acc[ai][bj][m][n];
                        *(f32x4*)(out + (size_t)row * D + col) = r;
                    }
            }
    }
};

__device__ __forceinline__ void phase_mods(const Params& p, float* smem, float* mods) {
    const int tid = threadIdx.x;
    for (int i = tid; i < 9 * 1024; i += 512) { const int b = i >> 10, k = i & 1023; const float v = (b < 8) ? p.c[b * 1024 + k] : p.c_ctx[k]; smem[i] = silu_f(v); }
    __syncthreads();
    float* red = smem + 9 * 1024;
    for (int item = blockIdx.x; item < 144; item += gridDim.x) {
        const int cl = tid & 63, kg = tid >> 6, col = item * 64 + cl;
        float acc[9];
#pragma unroll
        for (int b = 0; b < 9; ++b) acc[b] = 0.f;
        for (int k = kg * 128; k < kg * 128 + 128; ++k) {
            const float w = p.w_ada[(size_t)k * NMOD + col];
#pragma unroll
            for (int b = 0; b < 9; ++b) acc[b] += smem[b * 1024 + k] * w;
        }
#pragma unroll
        for (int b = 0; b < 9; ++b) red[(kg * 9 + b) * 64 + cl] = acc[b];
        __syncthreads();
        for (int o = tid; o < 9 * 64; o += 512) {
            const int b = o >> 6, cc = o & 63; float s = p.b_ada[item * 64 + cc];
            for (int g = 0; g < 8; ++g) s += red[(g * 9 + b) * 64 + cc];
            mods[(size_t)b * NMOD + item * 64 + cc] = s;
        }
        __syncthreads();
    }
}
__device__ __forceinline__ int map_src(int map, int n) {
    if (map == 0) return n;
    if (map == 1) { const int pn = n >> 8, r = n & 255, hid = pn * 128 + (r & 127); return (r < 128) ? hid : DFF + hid; }
    if (n < 3072) return n;
    if (n < 4096) return 3104 + (n - 3072);
    if (n < 4608) return 4128 + (n - 4096);
    if (n < 6656) return 4640 + (n - 4608);
    if (n < 6688) return 3072 + (n - 6656);
    return -1;
}
__device__ __forceinline__ void tconv(const float* src, bf16_t* dst, int K, int N, int Np, int map, int& off, float* tile) {
    const int tk = K / 64, nt = tk * (Np / 64), G = gridDim.x, tid = threadIdx.x;
    const int start = (int)((blockIdx.x + G - (off % G)) % G); off += nt;
    float* tile2 = tile + 64 * 65;
    for (int t = start; t < nt; t += 2 * G) {
        const int t2 = t + G; const bool has2 = t2 < nt;
        const int n0 = (t / tk) * 64, k0 = (t % tk) * 64, n02 = has2 ? (t2 / tk) * 64 : n0, k02 = has2 ? (t2 % tk) * 64 : k0;
        { const int nl = tid & 63, sn = map_src(map, n0 + nl), sn2 = map_src(map, n02 + nl);
          float va[8], vb[8];
#pragma unroll
          for (int i = 0; i < 8; ++i) { const int kl = (tid >> 6) + 8 * i; va[i] = (sn >= 0) ? src[(size_t)(k0 + kl) * N + sn] : 0.f; vb[i] = (sn2 >= 0) ? src[(size_t)(k02 + kl) * N + sn2] : 0.f; }
#pragma unroll
          for (int i = 0; i < 8; ++i) { const int kl = (tid >> 6) + 8 * i; tile[kl * 65 + nl] = va[i]; tile2[kl * 65 + nl] = vb[i]; } }
        __syncthreads();
        { const int kl2 = (tid & 31) * 2;
#pragma unroll
          for (int i = 0; i < 4; ++i) { const int nl = (tid >> 5) + 16 * i;
              *(unsigned*)(dst + (size_t)(n0 + nl) * K + k0 + kl2) = cvt_pk_bf16(tile[kl2 * 65 + nl], tile[(kl2 + 1) * 65 + nl]);
              if (has2) *(unsigned*)(dst + (size_t)(n02 + nl) * K + k02 + kl2) = cvt_pk_bf16(tile2[kl2 * 65 + nl], tile2[(kl2 + 1) * 65 + nl]); } }
        __syncthreads();
    }
}

template <int SRC>
__device__ __forceinline__ void normmod_load(const float* x, const float* ctx, const bf16_t* sb, int row, int lane, float (&v)[16]) {
    if (SRC == 1) {
        const bf16_t* s = sb + (size_t)row * D + lane * 4;
#pragma unroll
        for (int i = 0; i < 4; ++i) { const u32x2 q = *(const u32x2*)(s + 256 * i); v[4 * i] = bflo(q[0]); v[4 * i + 1] = bfhi(q[0]); v[4 * i + 2] = bflo(q[1]); v[4 * i + 3] = bfhi(q[1]); }
    } else {
        const float* s = ((SRC == 0 && row >= ML) ? ctx + (size_t)(row - ML) * D : x + (size_t)row * D) + lane * 4;
#pragma unroll
        for (int i = 0; i < 4; ++i) { const f32x4 q = *(const f32x4*)(s + 256 * i); v[4 * i] = q[0]; v[4 * i + 1] = q[1]; v[4 * i + 2] = q[2]; v[4 * i + 3] = q[3]; }
    }
}
__device__ __forceinline__ void normmod_finish(int row, int lane, const float (&v)[16], bf16_t* dst, const float* nw, const float* mods, int shift_i, int scale_i) {
    const int b = row < ML ? (row >> 13) : 8;
    float ss = 0.f;
#pragma unroll
    for (int i = 0; i < 16; ++i) ss += v[i] * v[i];
    ss = wave_sum(ss);
    const float rstd = rsqrtf(ss * (1.f / 1024.f) + 1e-6f);
    const float* mb = mods + (size_t)b * NMOD;
#pragma unroll
    for (int i = 0; i < 4; ++i) {
        const int col = lane * 4 + 256 * i;
        const f32x4 w = *(const f32x4*)(nw + col), sc = *(const f32x4*)(mb + scale_i * 1024 + col), sh = *(const f32x4*)(mb + shift_i * 1024 + col);
        float y[4];
#pragma unroll
        for (int j = 0; j < 4; ++j) y[j] = v[4 * i + j] * rstd * w[j] * (1.f + sc[j]) + sh[j];
        u32x2 o; o[0] = cvt_pk_bf16(y[0], y[1]); o[1] = cvt_pk_bf16(y[2], y[3]);
        *(u32x2*)(dst + (size_t)row * D + col) = o;
    }
}
template <int SRC>
__device__ __forceinline__ void phase_normmod(const float* x, const float* ctx, const bf16_t* sb, bf16_t* dst, const float* nw, const float* mods, int shift_i, int scale_i, int nrows, int row_begin, int wg, int nwg) {
    const int wave = threadIdx.x >> 6, lane = threadIdx.x & 63, step = nwg * 8;
    for (int row = row_begin + wg * 8 + wave; row < nrows; row += 2 * step) {
        const int rowb = row + step; const bool hasb = rowb < nrows;
        float va[16], vb[16];
        normmod_load<SRC>(x, ctx, sb, row, lane, va);
        if (hasb) normmod_load<SRC>(x, ctx, sb, rowb, lane, vb);
        normmod_finish(row, lane, va, dst, nw, mods, shift_i, scale_i);
        if (hasb) normmod_finish(rowb, lane, vb, dst, nw, mods, shift_i, scale_i);
    }
}
__device__ __forceinline__ void phase_final_norm(float* out, const float* w) {
    const int wave = threadIdx.x >> 6, lane = threadIdx.x & 63, step = gridDim.x * 8;
    for (int row = blockIdx.x * 8 + wave; row < ML; row += 2 * step) {
        float* s0 = out + (size_t)row * D + lane * 4; float* s1 = out + (size_t)((row + step < ML) ? row + step : row) * D + lane * 4;
        f32x4 q0[4], q1[4]; float ss0 = 0.f, ss1 = 0.f;
#pragma unroll
        for (int i = 0; i < 4; ++i) { q0[i] = *(const f32x4*)(s0 + 256 * i); q1[i] = *(const f32x4*)(s1 + 256 * i); }
#pragma unroll
        for (int i = 0; i < 4; ++i) { ss0 += q0[i][0] * q0[i][0] + q0[i][1] * q0[i][1] + q0[i][2] * q0[i][2] + q0[i][3] * q0[i][3]; ss1 += q1[i][0] * q1[i][0] + q1[i][1] * q1[i][1] + q1[i][2] * q1[i][2] + q1[i][3] * q1[i][3]; }
        ss0 = wave_sum(ss0); ss1 = wave_sum(ss1);
        const float r0 = rsqrtf(ss0 * (1.f / 1024.f) + 1e-6f), r1 = rsqrtf(ss1 * (1.f / 1024.f) + 1e-6f);
#pragma unroll
        for (int i = 0; i < 4; ++i) { const f32x4 ww = *(const f32x4*)(w + lane * 4 + 256 * i); *(f32x4*)(s0 + 256 * i) = q0[i] * r0 * ww; *(f32x4*)(s1 + 256 * i) = q1[i] * r1 * ww; }
    }
}

__device__ __forceinline__ void phase_conv(const Params& p, bf16_t* QKV, const bf16_t* SIDE, float* BG) {
    const int tid = threadIdx.x, rg = tid >> 6, cp = tid & 63;
    constexpr int NITEMS = (MT / 64) * 24;
    unsigned qn[12]; f32x2_t wn[5];
#define CONV_LOAD(ITEM) do { const int tile_ = (ITEM) / 24, cgp_ = (ITEM) % 24, t0_ = tile_ * 64, ch_ = cgp_ * 128 + cp * 2; \
        const bool first_ = tile_ < 1024 ? ((tile_ & 127) == 0) : (((tile_ - 1024) & 3) == 0); \
        const bool last_ = tile_ < 1024 ? ((tile_ & 127) == 127) : (((tile_ - 1024) & 3) == 3); \
        _Pragma("unroll") for (int i = 0; i < 12; ++i) { const int lr = rg * 8 - 2 + i; unsigned q = 0u; \
            if (lr >= 0 && lr < 64) q = *(const unsigned*)(QKV + (size_t)(t0_ + lr) * 3072 + ch_); \
            else if (lr < 0) { if (!first_) q = *(const unsigned*)(SIDE + ((size_t)(tile_ - 1) * 4 + (4 + lr)) * 3072 + ch_); } \
            else { if (!last_) q = *(const unsigned*)(SIDE + ((size_t)(tile_ + 1) * 4 + (lr - 64)) * 3072 + ch_); } \
            qn[i] = q; } \
        _Pragma("unroll") for (int k = 0; k < 5; ++k) wn[k] = *(const f32x2_t*)(p.conv_w + k * 3072 + ch_); } while (0)
    int item = blockIdx.x;
    if (item < NITEMS) CONV_LOAD(item);
    bool firstiter = true;
    for (; item < NITEMS; item += gridDim.x) {
        const int tile = item / 24, cgp = item % 24, t0 = tile * 64, ch = cgp * 128 + cp * 2;
        if (firstiter) asm volatile("s_waitcnt vmcnt(0)" ::: "memory"); else asm volatile("s_waitcnt vmcnt(8)" ::: "memory");
        firstiter = false;
        f32x2_t rr[12], wk[5];
#pragma unroll
        for (int i = 0; i < 12; ++i) { rr[i][0] = bflo(qn[i]); rr[i][1] = bfhi(qn[i]); }
#pragma unroll
        for (int k = 0; k < 5; ++k) wk[k] = wn[k];
        asm volatile("" ::: "memory");
        __syncthreads();
        if (item + (int)gridDim.x < NITEMS) CONV_LOAD(item + (int)gridDim.x);
        const float post = cgp < 8 ? 0.08838834764831845f : 1.f;
        f32x2_t y[8]; float ssq[8];
#pragma unroll
        for (int r = 0; r < 8; ++r) {
            f32x2_t acc = wk[0] * rr[r];
#pragma unroll
            for (int k = 1; k < 5; ++k) acc = acc + wk[k] * rr[r + k];
            const f32x2_t ne = acc * -1.4426950408889634f;
            f32x2_t d; d[0] = __builtin_amdgcn_exp2f(ne[0]); d[1] = __builtin_amdgcn_exp2f(ne[1]);
            d = d + 1.0f;
            f32x2_t rc; rc[0] = __builtin_amdgcn_rcpf(d[0]); rc[1] = __builtin_amdgcn_rcpf(d[1]);
            y[r] = acc * rc;
            const f32x2_t sq = y[r] * y[r];
            ssq[r] = sq[0] + sq[1];
        }
        if (cgp < 16) {
            const bool b0 = (cp & 1) != 0, b1 = (cp & 2) != 0, b2 = (cp & 4) != 0;
            float t4[4], t2[2], t1;
#pragma unroll
            for (int i = 0; i < 4; ++i) { const float keep = b0 ? ssq[i + 4] : ssq[i], send = b0 ? ssq[i] : ssq[i + 4]; t4[i] = keep + __shfl_xor(send, 1); }
#pragma unroll
            for (int i = 0; i < 2; ++i) { const float keep = b1 ? t4[i + 2] : t4[i], send = b1 ? t4[i] : t4[i + 2]; t2[i] = keep + __shfl_xor(send, 2); }
            { const float keep = b2 ? t2[1] : t2[0], send = b2 ? t2[0] : t2[1]; t1 = keep + __shfl_xor(send, 4); }
            t1 += __shfl_xor(t1, 8); t1 += __shfl_xor(t1, 16); t1 += __shfl_xor(t1, 32);
#pragma unroll
            for (int r = 0; r < 8; ++r) {
                const float tot = __int_as_float(__builtin_amdgcn_readlane(__float_as_int(t1), ((r >> 2) & 1) | (((r >> 1) & 1) << 1) | ((r & 1) << 2)));
                const float sc = rsqrtf(tot + 1e-6f) * post;
                y[r] = y[r] * sc;
            }
        }
#pragma unroll
        for (int r = 0; r < 8; ++r) *(unsigned*)(QKV + (size_t)(t0 + rg * 8 + r) * 3072 + ch) = cvt_pk_bf16(y[r][0], y[r][1]);
    }
#undef CONV_LOAD
    __syncthreads();
    { const int wave = tid >> 6, lane = tid & 63;
      for (int chunk = blockIdx.x * 8 + wave; chunk < MT / 64; chunk += gridDim.x * 8) {
          float* row = BG + ((size_t)chunk * 64 + lane) * 32 + 16;
          f32x4 g[4];
#pragma unroll
          for (int q = 0; q < 4; ++q) g[q] = *(const f32x4*)(row + 4 * q);
#pragma unroll
          for (int o = 1; o < 64; o <<= 1) {
#pragma unroll
              for (int q = 0; q < 4; ++q)
#pragma unroll
                  for (int e = 0; e < 4; ++e) {
                      const float up = __shfl_up(g[q][e], o), dn = __shfl_down(g[q][e], o);
                      if (q < 2) { if (lane >= o) g[q][e] += up; } else { if (lane + o < 64) g[q][e] += dn; }
                  }
          }
#pragma unroll
          for (int q = 0; q < 4; ++q) *(f32x4*)(row + 4 * q) = g[q];
      } }
}

template <int K>
__device__ __forceinline__ f32x4 mma_tile(const bf16_t* A, int lda, int row0, const bf16_t* Bt, int ldb, int col0, int lane) {
    f32x4 acc = {0.f, 0.f, 0.f, 0.f};
    const bf16_t* ap = A + (row0 + (lane & 15)) * lda + 8 * (lane >> 4);
    const bf16_t* bp = Bt + (col0 + (lane & 15)) * ldb + 8 * (lane >> 4);
#pragma unroll
    for (int k0 = 0; k0 < K; k0 += 32) acc = __builtin_amdgcn_mfma_f32_16x16x32_bf16(*(const bf16x8*)(ap + k0), *(const bf16x8*)(bp + k0), acc, 0, 0, 0);
    return acc;
}
constexpr int G_K = 0, G_KT = 17408, G_Q = 35840, G_V = 53248, G_ST = 61440, G_TB = 78848, G_AQK = 88064, G_NT = 97280, G_MROW = 106496, G_MT = 115712,
              G_PROW = 124928, G_RT = 134144, G_DINV = 143360, G_DINVT = 145408, G_M2T = 147456, G_DL = 147968, G_VEC = 152064, G_OS = 154112;
constexpr int G_VNT = G_MROW, G_VDT = G_MT;

__device__ __forceinline__ bf16x8 ld_frag_half(const bf16_t* p, int lq) {
    bf16x8 z = {0, 0, 0, 0, 0, 0, 0, 0};
    return lq < 2 ? *(const bf16x8*)p : z;
}

__device__ __forceinline__ void phase_gdn(unsigned char* sm, const bf16_t* QKV, const float* BG, bf16_t* OF, bf16_t* OB) {
    const int tid0 = threadIdx.x, wave = __builtin_amdgcn_readfirstlane(tid0 >> 6);
    bf16_t* Ks = (bf16_t*)(sm + G_K); bf16_t* KTs = (bf16_t*)(sm + G_KT); bf16_t* Qs = (bf16_t*)(sm + G_Q); bf16_t* Vs = (bf16_t*)(sm + G_V);
    bf16_t* STs = (bf16_t*)(sm + G_ST); bf16_t* TBs = (bf16_t*)(sm + G_TB); bf16_t* AQs = (bf16_t*)(sm + G_AQK);
    bf16_t* NTs = (bf16_t*)(sm + G_NT); bf16_t* MROW = (bf16_t*)(sm + G_MROW); bf16_t* MTs = (bf16_t*)(sm + G_MT); bf16_t* PROW = (bf16_t*)(sm + G_PROW);
    bf16_t* DINV = (bf16_t*)(sm + G_DINV); bf16_t* DINVT = (bf16_t*)(sm + G_DINVT); bf16_t* M2R = (bf16_t*)(sm + G_M2T);
    float* DL = (float*)(sm + G_DL); float* VEC = (float*)(sm + G_VEC); bf16_t* OSs = (bf16_t*)(sm + G_OS);
    bf16_t* RTs = (bf16_t*)(sm + G_RT); bf16_t* VNs = (bf16_t*)(sm + G_VNT); bf16_t* VDs = (bf16_t*)(sm + G_VDT);
    float* betas = VEC; float* cums = VEC + 64; float* ecums = VEC + 128; float* dds = VEC + 192;
    const int rb = wave >> 1, chh = wave & 1;
    for (int item = blockIdx.x; item < 256; item += gridDim.x) {
        const int half = item & 1, dir = (item >> 1) & 1, h = (item >> 2) & 7, b = item >> 5;
        f32x4 S[4];
#pragma unroll
        for (int n = 0; n < 4; ++n) S[n] = (f32x4){0.f, 0.f, 0.f, 0.f};
        for (int i = tid0; i < 64 * 136 / 2; i += 512) ((unsigned*)STs)[i] = 0u;
        for (int i = tid0; i < 64 * 72 / 2; i += 512) { ((unsigned*)TBs)[i] = 0u; ((unsigned*)AQs)[i] = 0u; }
        bf16_t* O = dir ? OB : OF;
        u32x4 pk0, pk1, pq0, pq1, pv; float pbeta = 0.f, pg = 0.f;
#define GDN_TOK(ci, i) ((ci) < 4 ? (ML + b * 256 + (dir ? 255 - 64 * (ci) - (i) : 64 * (ci) + (i))) : (b * 8192 + (dir ? 8191 - 64 * ((ci) - 4) - (i) : 64 * ((ci) - 4) + (i))))
#define GDN_ISSUE(ci) do { \
            { const size_t ta = (size_t)GDN_TOK(ci, lane) * 3072 + 128 * h + 16 * wave; \
              pk0 = *(const u32x4*)(QKV + ta + 1024); pk1 = *(const u32x4*)(QKV + ta + 1024 + 8); \
              pq0 = *(const u32x4*)(QKV + ta); pq1 = *(const u32x4*)(QKV + ta + 8); \
              pv = *(const u32x4*)(QKV + (size_t)GDN_TOK(ci, lane) * 3072 + 2048 + 128 * h + 64 * half + 8 * wave); } \
            if (wave == 0) { const size_t tk = (size_t)GDN_TOK(ci, lane) * 32; pbeta = BG[tk + dir * 8 + h]; pg = BG[tk + 16 + dir * 8 + h]; } } while (0)
        { const int tid = tid0, lane = tid & 63; GDN_ISSUE(0); }
        for (int ci = 0; ci < 132; ++ci) {
            int tid_o = tid0; asm volatile("" : "+v"(tid_o));
            const int tid = tid_o, lane = tid & 63, l15 = lane & 15, lq = lane >> 4;
            { *(u32x4*)(Ks + lane * 136 + 16 * wave) = pk0; *(u32x4*)(Ks + lane * 136 + 16 * wave + 8) = pk1;
              *(u32x4*)(Qs + lane * 136 + 16 * wave) = pq0; *(u32x4*)(Qs + lane * 136 + 16 * wave + 8) = pq1;
#pragma unroll
              for (int e = 0; e < 4; ++e) {
                  KTs[(16 * wave + 2 * e) * 72 + lane] = (bf16_t)(pk0[e] & 0xffffu); KTs[(16 * wave + 2 * e + 1) * 72 + lane] = (bf16_t)(pk0[e] >> 16);
                  KTs[(16 * wave + 8 + 2 * e) * 72 + lane] = (bf16_t)(pk1[e] & 0xffffu); KTs[(16 * wave + 8 + 2 * e + 1) * 72 + lane] = (bf16_t)(pk1[e] >> 16);
              }
              *(u32x4*)(Vs + lane * 64 + 8 * wave) = pv; }
            if (wave == 0) {
                const float c = pg;
                const float cl = __shfl(c, 63);
                betas[lane] = pbeta; cums[lane] = c; ecums[lane] = __expf(c); dds[lane] = __expf(cl - c);
                if (lane == 63) VEC[256] = __expf(c);
            }
            __syncthreads();
            if (ci >= 5) { const int orow = tid >> 3, opc = tid & 7; *(u32x4*)(O + (size_t)GDN_TOK(ci - 1, orow) * 1024 + 128 * h + 64 * half + 8 * opc) = *(const u32x4*)(OSs + orow * 72 + 8 * opc); }
            if (ci + 1 < 132) GDN_ISSUE(ci + 1);
#pragma unroll
            for (int n = 0; n < 2; ++n) {
                const int col0 = 32 * chh + 16 * n;
                const f32x4 KS = mma_tile<128>(Ks, 136, 16 * rb, STs, 136, col0, lane);
                const int c = col0 + l15, i0 = 16 * rb + 4 * lq;
                const f32x4 b4 = *(const f32x4*)(betas + i0), e4 = *(const f32x4*)(ecums + i0);
                f32x4 v4; v4[0] = bf2f(Vs[i0 * 64 + c]); v4[1] = bf2f(Vs[(i0 + 1) * 64 + c]); v4[2] = bf2f(Vs[(i0 + 2) * 64 + c]); v4[3] = bf2f(Vs[(i0 + 3) * 64 + c]);
                const f32x4 r = b4 * (v4 - e4 * KS);
                u32x2 o; o[0] = cvt_pk_bf16(r[0], r[1]); o[1] = cvt_pk_bf16(r[2], r[3]);
                *(u32x2*)(RTs + c * 72 + i0) = o;
            }
            {
                const int tabv = (wave < 4) ? (wave | wave << 2)
                               : (wave == 4) ? (1 | 0 << 2 | 1 << 4 | 2 << 5 | 0 << 7) : (wave == 5) ? (2 | 1 << 2) : (wave == 6) ? (3 | 0 << 2 | 1 << 4 | 3 << 5 | 1 << 7) : (3 | 2 << 2);
                const int ntile = 1 + ((tabv >> 4) & 1);
                for (int tix = 0; tix < ntile; ++tix) {
                    const int trb = tix ? ((tabv >> 5) & 3) : (tabv & 3), tcb = tix ? ((tabv >> 7) & 3) : ((tabv >> 2) & 3), col0 = 16 * tcb;
                    const f32x4 P = mma_tile<128>(Ks, 136, 16 * trb, Ks, 136, col0, lane);
                    const f32x4 P2 = mma_tile<128>(Qs, 136, 16 * trb, Ks, 136, col0, lane);
                    const int j = col0 + l15; const float cj = cums[j];
                    const f32x4 ci4 = *(const f32x4*)(cums + 16 * trb + 4 * lq), bi4 = *(const f32x4*)(betas + 16 * trb + 4 * lq);
                    float lv[4];
                    if (tcb == trb) {
#pragma unroll
                        for (int r = 0; r < 4; ++r) {
                            const int i = 16 * trb + 4 * lq + r;
                            const float dec = (i >= j) ? __expf(ci4[r] - cj) : 0.f;
                            lv[r] = (i > j) ? bi4[r] * P[r] * dec : 0.f;
                            AQs[i * 72 + j] = f2bf(P2[r] * dec);
                        }
                    } else {
                        const f32x4 ex = (ci4 - cj) * 1.4426950408889634f;
                        f32x4 dec4; dec4[0] = __builtin_amdgcn_exp2f(ex[0]); dec4[1] = __builtin_amdgcn_exp2f(ex[1]); dec4[2] = __builtin_amdgcn_exp2f(ex[2]); dec4[3] = __builtin_amdgcn_exp2f(ex[3]);
                        const f32x4 l4 = bi4 * P * dec4, a4 = P2 * dec4;
#pragma unroll
                        for (int r = 0; r < 4; ++r) { lv[r] = l4[r]; AQs[(16 * trb + 4 * lq + r) * 72 + j] = f2bf(a4[r]); }
                    }
                    if (tcb == trb) {
                        *(f32x4*)(DL + trb * 256 + l15 * 16 + 4 * lq) = (f32x4){lv[0], lv[1], lv[2], lv[3]};
                        __builtin_amdgcn_fence(__ATOMIC_RELEASE, "wavefront"); __builtin_amdgcn_wave_barrier(); __builtin_amdgcn_fence(__ATOMIC_ACQUIRE, "wavefront");
                        if (lane < 16) {
                            const int blk = trb, c = lane;
                            const float* dl = DL + blk * 256;
                            f32x2_t sp[8];
#pragma unroll
                            for (int k = 0; k < 8; ++k) { sp[k][0] = (2 * k == c) ? 1.f : 0.f; sp[k][1] = (2 * k + 1 == c) ? 1.f : 0.f; }
#pragma unroll
                            for (int j = 0; j < 15; ++j) {
                                const float xj = sp[j >> 1][j & 1];
                                const f32x2_t xj2 = {xj, xj};
                                if ((j & 1) == 0) sp[j >> 1][1] -= dl[j * 16 + j + 1] * xj;
#pragma unroll
                                for (int k = (j >> 1) + 1; k < 8; ++k) { const f32x2_t l2 = *(const f32x2_t*)(dl + j * 16 + 2 * k); sp[k] = sp[k] - l2 * xj2; }
                            }
#pragma unroll
                            for (int i = 0; i < 16; ++i) DINV[blk * 256 + i * 16 + c] = f2bf(sp[i >> 1][i & 1]);
                            u32x4 t0, t1;
#pragma unroll
                            for (int e = 0; e < 4; ++e) { t0[e] = cvt_pk_bf16(sp[e][0], sp[e][1]); t1[e] = cvt_pk_bf16(sp[4 + e][0], sp[4 + e][1]); }
                            *(u32x4*)(DINVT + blk * 256 + c * 16) = t0; *(u32x4*)(DINVT + blk * 256 + c * 16 + 8) = t1;
                        }
                    } else {
                        u32x2 o; o[0] = cvt_pk_bf16(lv[0], lv[1]); o[1] = cvt_pk_bf16(lv[2], lv[3]);
                        *(u32x2*)(NTs + (col0 + l15) * 72 + 16 * trb + 4 * lq) = o;
                    }
                }
            }
            __syncthreads();
            f32x4 mreg[2], m2reg[2];
#pragma unroll
            for (int n = 0; n < 2; ++n) {
                const int cb = 2 * chh + n;
                mreg[n] = (f32x4){0.f, 0.f, 0.f, 0.f}; m2reg[n] = (f32x4){0.f, 0.f, 0.f, 0.f};
                if (cb < rb) {
                    const bf16x8 a = ld_frag_half(DINV + rb * 256 + l15 * 16 + 8 * lq, lq);
                    const bf16x8 bq = ld_frag_half(NTs + (16 * cb + l15) * 72 + 16 * rb + 8 * lq, lq);
                    mreg[n] = __builtin_amdgcn_mfma_f32_16x16x32_bf16(a, bq, mreg[n], 0, 0, 0);
#pragma unroll
                    for (int r = 0; r < 4; ++r) MROW[(16 * rb + 4 * lq + r) * 72 + 16 * cb + l15] = f2bf(mreg[n][r]);
                    u32x2 o; o[0] = cvt_pk_bf16(mreg[n][0], mreg[n][1]); o[1] = cvt_pk_bf16(mreg[n][2], mreg[n][3]);
                    *(u32x2*)(MTs + (16 * cb + l15) * 72 + 16 * rb + 4 * lq) = o;
                }
            }
            __syncthreads();
#pragma unroll
            for (int nn = 0; nn < 2; ++nn) {
                const int n = 1 - nn, cb = 2 * chh + n;
                if (cb <= rb) {
                    f32x4 m3 = {0.f, 0.f, 0.f, 0.f};
                    if (rb - cb >= 2) {
                        const int k0 = 16 * (cb + 1); const bool wide = (rb - cb == 3);
                        const bf16x8 z = {0, 0, 0, 0, 0, 0, 0, 0};
                        const bf16x8 a = (wide || lq < 2) ? *(const bf16x8*)(MROW + (16 * rb + l15) * 72 + k0 + 8 * lq) : z;
                        const bf16x8 bq = (wide || lq < 2) ? *(const bf16x8*)(MTs + (16 * cb + l15) * 72 + k0 + 8 * lq) : z;
                        m2reg[n] = __builtin_amdgcn_mfma_f32_16x16x32_bf16(a, bq, m2reg[n], 0, 0, 0);
                        if (rb == 3 && cb == 1) {
#pragma unroll
                            for (int r = 0; r < 4; ++r) M2R[(4 * lq + r) * 16 + l15] = f2bf(m2reg[n][r]);
                            __builtin_amdgcn_fence(__ATOMIC_RELEASE, "wavefront"); __builtin_amdgcn_wave_barrier(); __builtin_amdgcn_fence(__ATOMIC_ACQUIRE, "wavefront");
                        }
                        if (rb == 3 && cb == 0) {
                            const bf16x8 a3 = ld_frag_half(M2R + l15 * 16 + 8 * lq, lq);
                            const bf16x8 b3 = ld_frag_half(MTs + l15 * 72 + 16 + 8 * lq, lq);
                            m3 = __builtin_amdgcn_mfma_f32_16x16x32_bf16(a3, b3, m3, 0, 0, 0);
                        }
                    }
#pragma unroll
                    for (int r = 0; r < 4; ++r) {
                        const float idv = (cb == rb && (4 * lq + r) == l15) ? 1.f : 0.f;
                        PROW[(16 * rb + 4 * lq + r) * 72 + 16 * cb + l15] = f2bf(idv + m2reg[n][r] - mreg[n][r] - m3[r]);
                    }
                    __builtin_amdgcn_fence(__ATOMIC_RELEASE, "wavefront"); __builtin_amdgcn_wave_barrier(); __builtin_amdgcn_fence(__ATOMIC_ACQUIRE, "wavefront");
                    const bf16x8 a = ld_frag_half(PROW + (16 * rb + l15) * 72 + 16 * cb + 8 * lq, lq);
                    const bf16x8 bq = ld_frag_half(DINVT + cb * 256 + l15 * 16 + 8 * lq, lq);
                    f32x4 t = {0.f, 0.f, 0.f, 0.f};
                    t = __builtin_amdgcn_mfma_f32_16x16x32_bf16(a, bq, t, 0, 0, 0);
#pragma unroll
                    for (int r = 0; r < 4; ++r) TBs[(16 * rb + 4 * lq + r) * 72 + 16 * cb + l15] = f2bf(t[r]);
                }
            }
            __syncthreads();
#pragma unroll
            for (int n = 0; n < 2; ++n) {
                const int col0 = 32 * chh + 16 * n;
                const f32x4 VN = mma_tile<64>(TBs, 72, 16 * rb, RTs, 72, col0, lane);
                const int c = col0 + l15, i0 = 16 * rb + 4 * lq;
                u32x2 o; o[0] = cvt_pk_bf16(VN[0], VN[1]); o[1] = cvt_pk_bf16(VN[2], VN[3]);
                *(u32x2*)(VNs + c * 72 + i0) = o;
                const f32x4 d4 = *(const f32x4*)(dds + i0);
                const f32x4 vd = VN * d4;
                u32x2 o2; o2[0] = cvt_pk_bf16(vd[0], vd[1]); o2[1] = cvt_pk_bf16(vd[2], vd[3]);
                *(u32x2*)(VDs + c * 72 + i0) = o2;
            }
            __syncthreads();
            if (ci >= 4) {
#pragma unroll
                for (int n = 0; n < 2; ++n) {
                    const int col0 = 32 * chh + 16 * n;
                    const f32x4 A1 = mma_tile<128>(Qs, 136, 16 * rb, STs, 136, col0, lane);
                    const f32x4 A2 = mma_tile<64>(AQs, 72, 16 * rb, VNs, 72, col0, lane);
                    const int c = col0 + l15, i0 = 16 * rb + 4 * lq;
                    const f32x4 e4 = *(const f32x4*)(ecums + i0);
                    const f32x4 ov = e4 * A1 + A2;
#pragma unroll
                    for (int q = 0; q < 4; ++q) { const int i = i0 + q; OSs[i * 72 + c] = f2bf(ov[q]); }
                }
            }
            { const float bl = VEC[256];
#pragma unroll
              for (int n = 0; n < 4; ++n) { const f32x4 A3 = mma_tile<64>(KTs, 72, 16 * wave, VDs, 72, 16 * n, lane); S[n] = S[n] * bl + A3; } }
            __syncthreads();
#pragma unroll
            for (int n = 0; n < 4; ++n) {
                const int c = 16 * n + l15, r0 = 16 * wave + 4 * lq;
                u32x2 o; o[0] = cvt_pk_bf16(S[n][0], S[n][1]); o[1] = cvt_pk_bf16(S[n][2], S[n][3]);
                *(u32x2*)(STs + c * 136 + r0) = o;
            }
        }
        __syncthreads();
        { const int tid = tid0, orow = tid >> 3, opc = tid & 7; *(u32x4*)(O + (size_t)GDN_TOK(131, orow) * 1024 + 128 * h + 64 * half + 8 * opc) = *(const u32x4*)(OSs + orow * 72 + 8 * opc); }
        __syncthreads();
#undef GDN_TOK
#undef GDN_ISSUE
    }
}

__device__ __forceinline__ void phase_pool(const Params& p, unsigned char* sm, const bf16_t* POOL, const bf16_t* WTPOOLW, bf16_t* PP) {
    const int tid = threadIdx.x, wave = tid >> 6, lane = tid & 63;
    float* Vsum = (float*)sm;
    bf16_t* As = (bf16_t*)(sm + 33792);
    const int c = tid >> 3, ch0 = (tid & 7) * 16;
    for (int item = blockIdx.x; item < 8 * 4 * 128; item += gridDim.x) {
        const int r = item & 127, g = (item >> 7) & 3, b = item >> 9;
        const int hw = 1 << g;
        const int rlo = max(r - hw, 0), rhi = min(r + hw, 128);
        float vs[16], xr[16];
#pragma unroll
        for (int e = 0; e < 16; ++e) vs[e] = 0.f;
        { const bf16_t* src = POOL + ((size_t)(b * 8192 + r * 64 + c)) * 512 + g * 128 + ch0;
          const u32x4 a = *(const u32x4*)src, bq = *(const u32x4*)(src + 8);
#pragma unroll
          for (int e = 0; e < 4; ++e) { xr[2 * e] = bflo(a[e]); xr[2 * e + 1] = bfhi(a[e]); xr[8 + 2 * e] = bflo(bq[e]); xr[8 + 2 * e + 1] = bfhi(bq[e]); } }
        for (int rr0 = rlo; rr0 < rhi; rr0 += 4) {
            u32x4 av[4], bv[4];
#pragma unroll
            for (int u = 0; u < 4; ++u) {
                const int rr = min(rr0 + u, rhi - 1);
                const bf16_t* src = POOL + ((size_t)(b * 8192 + rr * 64 + c)) * 512 + g * 128 + ch0;
                av[u] = *(const u32x4*)src; bv[u] = *(const u32x4*)(src + 8);
            }
#pragma unroll
            for (int u = 0; u < 4; ++u) {
                if (rr0 + u < rhi) {
#pragma unroll
                    for (int e = 0; e < 4; ++e) { vs[2 * e] += bflo(av[u][e]); vs[2 * e + 1] += bfhi(av[u][e]); vs[8 + 2 * e] += bflo(bv[u][e]); vs[8 + 2 * e + 1] += bfhi(bv[u][e]); }
                }
            }
        }
#pragma unroll
        for (int e = 0; e < 4; ++e) *(f32x4*)(Vsum + c * 132 + ch0 + 4 * e) = (f32x4){vs[4 * e], vs[4 * e + 1], vs[4 * e + 2], vs[4 * e + 3]};
        __syncthreads();
        const int clo = max(c - hw, 0), chi = min(c + hw, 64);
        float hs[16];
#pragma unroll
        for (int e = 0; e < 16; ++e) hs[e] = 0.f;
        for (int cc = clo; cc < chi; ++cc) {
#pragma unroll
            for (int e = 0; e < 4; ++e) { const f32x4 q = *(const f32x4*)(Vsum + cc * 132 + ch0 + 4 * e); hs[4 * e] += q[0]; hs[4 * e + 1] += q[1]; hs[4 * e + 2] += q[2]; hs[4 * e + 3] += q[3]; }
        }
        const float inv = 1.f / (float)((rhi - rlo) * (chi - clo));
        u32x4 o0, o1;
#pragma unroll
        for (int e = 0; e < 4; ++e) { o0[e] = cvt_pk_bf16(hs[2 * e] * inv - xr[2 * e], hs[2 * e + 1] * inv - xr[2 * e + 1]); o1[e] = cvt_pk_bf16(hs[8 + 2 * e] * inv - xr[8 + 2 * e], hs[8 + 2 * e + 1] * inv - xr[8 + 2 * e + 1]); }
        *(u32x4*)(As + c * 136 + ch0) = o0; *(u32x4*)(As + c * 136 + ch0 + 8) = o1;
        __syncthreads();
        const bf16_t* Bt = WTPOOLW + g * 16384 + (16 * wave + (lane & 15)) * 128 + 8 * (lane >> 4);
        bf16x8 bf[4];
#pragma unroll
        for (int ks = 0; ks < 4; ++ks) bf[ks] = *(const bf16x8*)(Bt + 32 * ks);
        const int e = 16 * wave + (lane & 15); const float sc = p.pool_scale[g * 128 + e];
#pragma unroll
        for (int rbk = 0; rbk < 4; ++rbk) {
            f32x4 acc = {0.f, 0.f, 0.f, 0.f};
#pragma unroll
            for (int ks = 0; ks < 4; ++ks) acc = __builtin_amdgcn_mfma_f32_16x16x32_bf16(*(const bf16x8*)(As + (16 * rbk + (lane & 15)) * 136 + 32 * ks + 8 * (lane >> 4)), bf[ks], acc, 0, 0, 0);
#pragma unroll
            for (int q = 0; q < 4; ++q) { const int tok = 16 * rbk + 4 * (lane >> 4) + q; PP[((size_t)(b * 8192 + r * 64 + tok)) * 512 + g * 128 + e] = f2bf(acc[q] * sc); }
        }
        __syncthreads();
    }
}

__device__ __forceinline__ void onorm_item(const Params& p, bf16_t* OF, size_t idx, const u32x4 a, const u32x4 bq, const u32x4 gq) {
    const size_t off = idx * 8; const int c8 = (int)(idx & 127) * 8;
    float o[8], ss = 0.f;
#pragma unroll
    for (int e = 0; e < 4; ++e) { o[2 * e] = bflo(a[e]) + bflo(bq[e]); o[2 * e + 1] = bfhi(a[e]) + bfhi(bq[e]); }
#pragma unroll
    for (int e = 0; e < 8; ++e) ss += o[e] * o[e];
    ss += __shfl_xor(ss, 1); ss += __shfl_xor(ss, 2); ss += __shfl_xor(ss, 4); ss += __shfl_xor(ss, 8);
    const float rstd = rsqrtf(ss * (1.f / 128.f) + 1e-6f);
    const f32x4 w0 = *(const f32x4*)(p.gdn_norm_w + (c8 & 127)), w1 = *(const f32x4*)(p.gdn_norm_w + (c8 & 127) + 4);
    u32x4 r;
    r[0] = cvt_pk_bf16(o[0] * rstd * w0[0] * bflo(gq[0]), o[1] * rstd * w0[1] * bfhi(gq[0]));
    r[1] = cvt_pk_bf16(o[2] * rstd * w0[2] * bflo(gq[1]), o[3] * rstd * w0[3] * bfhi(gq[1]));
    r[2] = cvt_pk_bf16(o[4] * rstd * w1[0] * bflo(gq[2]), o[5] * rstd * w1[1] * bfhi(gq[2]));
    r[3] = cvt_pk_bf16(o[6] * rstd * w1[2] * bflo(gq[3]), o[7] * rstd * w1[3] * bfhi(gq[3]));
    *(u32x4*)(OF + off) = r;
}
__device__ __forceinline__ void phase_onorm(const Params& p, bf16_t* OF, const bf16_t* OB, const bf16_t* GATE) {
    const size_t nthr = (size_t)gridDim.x * 512, total = (size_t)ML * 128;
    for (size_t idx = (size_t)blockIdx.x * 512 + threadIdx.x; idx < total; idx += 2 * nthr) {
        const size_t idx2 = (idx + nthr < total) ? idx + nthr : idx;
        const u32x4 a0 = *(const u32x4*)(OF + idx * 8), b0 = *(const u32x4*)(OB + idx * 8), g0 = *(const u32x4*)(GATE + idx * 8);
        const u32x4 a1 = *(const u32x4*)(OF + idx2 * 8), b1 = *(const u32x4*)(OB + idx2 * 8), g1 = *(const u32x4*)(GATE + idx2 * 8);
        onorm_item(p, OF, idx, a0, b0, g0);
        if (idx2 != idx) onorm_item(p, OF, idx2, a1, b1, g1);
    }
}

#define XB_TMO      128
#define XB_XCNT(j)  (256  + 64 * (j))
#define XB_XSUB(j)  (1280 + 64 * (j))
#define XB_XGEN(j)  (2304 + 64 * (j))
#define XB_TOP      3328
#define XB_TOPGEN   3392
#define XCD_BAR_WORDS 3456
#define XB_SPIN_CAP (1u << 18)
__device__ __forceinline__ unsigned xb_ld(unsigned* p)              { return __hip_atomic_load(p, __ATOMIC_RELAXED, __HIP_MEMORY_SCOPE_AGENT); }
__device__ __forceinline__ unsigned xb_add(unsigned* p, unsigned v) { return __hip_atomic_fetch_add(p, v, __ATOMIC_RELAXED, __HIP_MEMORY_SCOPE_AGENT); }
__device__ __forceinline__ unsigned xb_xcc_id() { return (unsigned)__builtin_amdgcn_s_getreg((3 << 11) | 20) & 0xFu; }
#define XB_SPIN(cond, bar) do { unsigned _sp = 0; while (cond) { __builtin_amdgcn_s_sleep(1); \
    if ((++_sp & 255u) == 0u) { if (xb_ld(&(bar)[XB_TMO])) break; if (_sp > XB_SPIN_CAP) { atomicAdd(&(bar)[XB_TMO], 1u); break; } } } } while (0)
struct XcdBarrier { unsigned* bar; unsigned x; volatile LAS unsigned* st; };
__device__ __forceinline__ XcdBarrier xcd_barrier_post(unsigned* bar, volatile LAS unsigned* st) {
    XcdBarrier b; b.bar = bar; b.x = xb_xcc_id(); b.st = st;
    if (threadIdx.x == 0) st[2] = xb_add(&bar[XB_XCNT(b.x)], 1u);
    return b;
}
__device__ __forceinline__ void xcd_barrier_complete(unsigned* bar, unsigned x, unsigned& nloc, unsigned& nx) {
    const unsigned G = gridDim.x * gridDim.y * gridDim.z;
    unsigned sum, cnt, mine, sp = 0u;
    for (;;) {
        sum = 0u; cnt = 0u; mine = 0u;
#pragma unroll
        for (unsigned j = 0; j < 16; ++j) { const unsigned c = xb_ld(&bar[XB_XCNT(j)]); sum += c; cnt += (c > 0u) ? 1u : 0u; mine = (j == x) ? c : mine; }
        if (sum == G) break;
        __builtin_amdgcn_s_sleep(1);
        if ((++sp & 255u) == 0u) { if (xb_ld(&bar[XB_TMO])) break; if (sp > XB_SPIN_CAP) { atomicAdd(&bar[XB_TMO], 1u); break; } }
    }
    nloc = mine > 0u ? mine : 1u; nx = cnt > 0u ? cnt : 1u;
}
__device__ __forceinline__ void xcd_barrier(const XcdBarrier& b) {
    asm volatile("s_waitcnt vmcnt(0)" ::: "memory");
    __syncthreads();
    if (threadIdx.x == 0) {
        unsigned* bar = b.bar;
        __builtin_amdgcn_s_waitcnt(0);
        unsigned nloc = b.st[0], nx = b.st[1];
        if (nloc == 0u) { xcd_barrier_complete(bar, b.x, nloc, nx); b.st[0] = nloc; b.st[1] = nx; }
        const unsigned old = xb_add(&bar[XB_XSUB(b.x)], 1u);
        const unsigned gen = old / nloc;
        if (old + 1u == (gen + 1u) * nloc) {
            __builtin_amdgcn_fence(__ATOMIC_RELEASE, "agent");
            asm volatile("s_waitcnt vmcnt(0)" ::: "memory");
            const unsigned og = xb_add(&bar[XB_TOP], 1u);
            const unsigned tg = og / nx;
            if (og + 1u == (tg + 1u) * nx) xb_add(&bar[XB_TOPGEN], 1u);
            else XB_SPIN(xb_ld(&bar[XB_TOPGEN]) == tg, bar);
            __builtin_amdgcn_fence(__ATOMIC_ACQUIRE, "agent");
            xb_add(&bar[XB_XGEN(b.x)], 1u);
            asm volatile("s_waitcnt vmcnt(0)" ::: "memory");
        } else {
            XB_SPIN(xb_ld(&bar[XB_XGEN(b.x)]) == gen, bar);
            __builtin_amdgcn_fence(__ATOMIC_ACQUIRE, "agent");
            asm volatile("s_waitcnt vmcnt(0)" ::: "memory");
        }
    }
    __syncthreads();
}

#define GSYNC() xcd_barrier(xb)
#define GSYNC_CG() do { asm volatile("s_waitcnt vmcnt(0) lgkmcnt(0)" ::: "memory"); grid.sync(); } while (0)
__global__ void __launch_bounds__(512, 2) fwd_megakernel(Params p) {
    extern __shared__ __attribute__((aligned(16))) unsigned char shm[];
    cg::grid_group grid = cg::this_grid();
    LAS unsigned char* lds = (LAS unsigned char*)shm;
    const int G = gridDim.x, bid = blockIdx.x;
    pg8::StaticOrder S;
    volatile LAS unsigned* xb_st = (volatile LAS unsigned*)(lds + (kDynLds - 16));
    if (threadIdx.x == 0) { xb_st[0] = 0u; xb_st[1] = 0u; }
    __syncthreads();
    const XcdBarrier xb = xcd_barrier_post((unsigned*)(p.ws + WS_BAR), xb_st);

    phase_mods(p, (float*)shm, ((float*)((unsigned char*)p.ws + WS_MODS)));
    { int off = 0; float* tile = (float*)shm;
      tconv(p.ffn1_w_in, ((bf16_t*)((unsigned char*)p.out + DO_WTFFN1IN)), 1024, 2 * DFF, 2 * DFF, 1, off, tile);
      tconv(p.ffn1_w_out, ((bf16_t*)((unsigned char*)p.out + DO_WTFFN1OUT)), DFF, 1024, 1024, 0, off, tile);
      tconv(p.w_mix_in, ((bf16_t*)((unsigned char*)p.out + DO_WTMIX)), 1024, 6688, NMIX, 2, off, tile);
      tconv(p.w_gdn_proj, ((bf16_t*)((unsigned char*)p.ws + WS_WTGDN)), 1024, 1024, 1024, 0, off, tile);
      tconv(p.w_pool_proj, ((bf16_t*)((unsigned char*)p.ws + WS_WTPOOL)), 512, 1024, 1024, 0, off, tile);
      tconv(p.w_mix_out, ((bf16_t*)((unsigned char*)p.ws + WS_WTMIXOUT)), 1024, 1024, 1024, 0, off, tile);
      tconv(p.ffn2_w_in, ((bf16_t*)((unsigned char*)p.ws + WS_WTFFN2IN)), 1024, 2 * DFF, 2 * DFF, 1, off, tile);
      tconv(p.ffn2_w_out, ((bf16_t*)((unsigned char*)p.ws + WS_WTFFN2OUT)), DFF, 1024, 1024, 0, off, tile);
      for (int g = 0; g < 4; ++g) tconv(p.pool_w + g * 16384, ((bf16_t*)((unsigned char*)p.ws + WS_WTPOOLW)) + g * 16384, 128, 128, 128, 0, off, tile); }
    GSYNC_CG();
    if (threadIdx.x == 0) {
        unsigned ok = ((unsigned)G % 8u == 0u && xb.x < 8u) ? 1u : 0u;
        for (unsigned j8 = 0; j8 < 8u; ++j8) ok &= (xb_ld(&xb.bar[XB_XCNT(j8)]) == (unsigned)G / 8u) ? 1u : 0u;
        xb_st[3] = ok ? (xb_st[2] * 8u + xb.x) : (unsigned)bid;
    }
    __syncthreads();
    const int cvirt = __builtin_amdgcn_readfirstlane((int)xb_st[3]);
    phase_normmod<0>(p.x, p.ctx, nullptr, ((bf16_t*)((unsigned char*)p.out + DO_H)), p.norm1_w, ((float*)((unsigned char*)p.ws + WS_MODS)), 0, 1, MT, 0, bid, G);
    GSYNC();
    { S.init(MT, 2 * DFF, G, cvirt); pg8::gemm_phase(lds, pg8::Gemm{((bf16_t*)((unsigned char*)p.out + DO_H)), ((bf16_t*)((unsigned char*)p.out + DO_WTFFN1IN)), MT, 2 * DFF, 1024}, S, EpiFfnA{((bf16_t*)((unsigned char*)p.ws + WS_HID))}); }
    GSYNC();
    { S.init(ML, 1024, G, cvirt); pg8::gemm_phase(lds, pg8::Gemm{((bf16_t*)((unsigned char*)p.ws + WS_HID)), ((bf16_t*)((unsigned char*)p.out + DO_WTFFN1OUT)), ML, 1024, DFF}, S, EpiFfnB<true>{p.x, p.ctx, ((bf16_t*)((unsigned char*)p.ws + WS_X1)), nullptr, ((float*)((unsigned char*)p.ws + WS_MODS)), 2, 0}); }
    GSYNC();
    if (cvirt < 32) { S.init(MC, 1024, 32, cvirt); pg8::gemm_phase(lds, pg8::Gemm{((bf16_t*)((unsigned char*)p.ws + WS_HID)) + (size_t)ML * DFF, ((bf16_t*)((unsigned char*)p.out + DO_WTFFN1OUT)), MC, 1024, DFF}, S, EpiFfnB<true>{p.x, p.ctx, ((bf16_t*)((unsigned char*)p.ws + WS_X1)), nullptr, ((float*)((unsigned char*)p.ws + WS_MODS)), 2, 256}); }
    else phase_normmod<1>(nullptr, nullptr, ((bf16_t*)((unsigned char*)p.ws + WS_X1)), ((bf16_t*)((unsigned char*)p.out + DO_H)), p.norm2_w, ((float*)((unsigned char*)p.ws + WS_MODS)), 3, 4, ML, 0, cvirt - 32, G - 32);
    GSYNC();
    phase_normmod<1>(nullptr, nullptr, ((bf16_t*)((unsigned char*)p.ws + WS_X1)), ((bf16_t*)((unsigned char*)p.out + DO_H)), p.norm2_w, ((float*)((unsigned char*)p.ws + WS_MODS)), 3, 4, MT, ML, bid, G);
    GSYNC();
    { S.init(MT, NMIX, G, cvirt); pg8::gemm_phase(lds, pg8::Gemm{((bf16_t*)((unsigned char*)p.out + DO_H)), ((bf16_t*)((unsigned char*)p.out + DO_WTMIX)), MT, NMIX, 1024}, S, EpiMix{((bf16_t*)((unsigned char*)p.ws + WS_QKV)), ((bf16_t*)((unsigned char*)p.out + DO_SIDE)), ((bf16_t*)((unsigned char*)p.ws + WS_GATE)), ((bf16_t*)((unsigned char*)p.ws + WS_POOL)), ((bf16_t*)((unsigned char*)p.ws + WS_MIXG)), ((float*)((unsigned char*)p.ws + WS_BG)), p.a_log, p.dt_bias}); }
    GSYNC();
    phase_conv(p, ((bf16_t*)((unsigned char*)p.ws + WS_QKV)), ((bf16_t*)((unsigned char*)p.out + DO_SIDE)), ((float*)((unsigned char*)p.ws + WS_BG)));
    GSYNC();
    phase_gdn(shm, ((bf16_t*)((unsigned char*)p.ws + WS_QKV)), ((float*)((unsigned char*)p.ws + WS_BG)), ((bf16_t*)((unsigned char*)p.out + DO_OF)), ((bf16_t*)((unsigned char*)p.out + DO_OB)));
    GSYNC();
    phase_pool(p, shm, ((bf16_t*)((unsigned char*)p.ws + WS_POOL)), ((bf16_t*)((unsigned char*)p.ws + WS_WTPOOLW)), ((bf16_t*)((unsigned char*)p.ws + WS_POOLPRE)));
    phase_onorm(p, ((bf16_t*)((unsigned char*)p.out + DO_OF)), ((bf16_t*)((unsigned char*)p.out + DO_OB)), ((bf16_t*)((unsigned char*)p.ws + WS_GATE)));
    GSYNC();
    { S.init(ML, 1024, G, cvirt); pg8::gemm_phase(lds, pg8::Gemm{((bf16_t*)((unsigned char*)p.ws + WS_POOLPRE)), ((bf16_t*)((unsigned char*)p.ws + WS_WTPOOL)), ML, 1024, 512}, S, EpiMerge<0>{((bf16_t*)((unsigned char*)p.ws + WS_MIXG)), nullptr, ((bf16_t*)((unsigned char*)p.ws + WS_T))}); }
    GSYNC();
    { S.init(ML, 1024, G, cvirt); pg8::gemm_phase(lds, pg8::Gemm{((bf16_t*)((unsigned char*)p.out + DO_OF)), ((bf16_t*)((unsigned char*)p.ws + WS_WTGDN)), ML, 1024, 1024}, S, EpiMerge<1>{((bf16_t*)((unsigned char*)p.ws + WS_MIXG)), ((bf16_t*)((unsigned char*)p.ws + WS_T)), ((bf16_t*)((unsigned char*)p.ws + WS_M))}); }
    GSYNC();
    { S.init(ML, 1024, G, cvirt); pg8::gemm_phase(lds, pg8::Gemm{((bf16_t*)((unsigned char*)p.ws + WS_M)), ((bf16_t*)((unsigned char*)p.ws + WS_WTMIXOUT)), ML, 1024, 1024}, S, EpiMixOut{((bf16_t*)((unsigned char*)p.ws + WS_X1)), p.out, ((float*)((unsigned char*)p.ws + WS_MODS))}); }
    GSYNC();
    phase_normmod<2>(p.out, nullptr, nullptr, ((bf16_t*)((unsigned char*)p.ws + WS_H3)), p.norm3_w, ((float*)((unsigned char*)p.ws + WS_MODS)), 6, 7, ML, 0, bid, G);
    GSYNC();
    { S.init(ML, 2 * DFF, G, cvirt); pg8::gemm_phase(lds, pg8::Gemm{((bf16_t*)((unsigned char*)p.ws + WS_H3)), ((bf16_t*)((unsigned char*)p.ws + WS_WTFFN2IN)), ML, 2 * DFF, 1024}, S, EpiFfnA{((bf16_t*)((unsigned char*)p.ws + WS_HID))}); }
    GSYNC();
    { S.init(ML, 1024, G, cvirt); pg8::gemm_phase(lds, pg8::Gemm{((bf16_t*)((unsigned char*)p.ws + WS_HID)), ((bf16_t*)((unsigned char*)p.ws + WS_WTFFN2OUT)), ML, 1024, DFF}, S, EpiFfnB<false>{nullptr, nullptr, nullptr, p.out, ((float*)((unsigned char*)p.ws + WS_MODS)), 8}); }
    GSYNC();
    phase_final_norm(p.out, p.final_norm_w);
}

extern "C" void kernel_launch(void* const* d_in, const int* in_sizes, int n_in, void* d_out, int out_size, void* d_ws, size_t ws_size, hipStream_t stream) {
    static int grid_blocks = 0;
    if (!grid_blocks) {
        hipFuncSetAttribute((const void*)fwd_megakernel, hipFuncAttributeMaxDynamicSharedMemorySize, (int)kDynLds);
        int dev = 0, cus = 0, per_cu = 0;
        hipGetDevice(&dev);
        hipDeviceGetAttribute(&cus, hipDeviceAttributeMultiprocessorCount, dev);
        hipOccupancyMaxActiveBlocksPerMultiprocessor(&per_cu, fwd_megakernel, 512, kDynLds);
        grid_blocks = cus * per_cu;
        if (grid_blocks > 256) grid_blocks = 256;
        if (grid_blocks <= 0) grid_blocks = 256;
    }
    if (ws_size < WS_TOTAL) { fprintf(stderr, "workspace too small: %zu < %zu\n", ws_size, (size_t)WS_TOTAL); return; }
    Params p{};
    const float** pp = (const float**)&p;
    for (int i = 0; i < 24; ++i) pp[i] = (const float*)d_in[i];
    p.out = (float*)d_out; p.ws = (unsigned char*)d_ws;
    (void)hipMemsetAsync((unsigned char*)d_ws + WS_BAR, 0, XCD_BAR_WORDS * 4, stream);
    void* args[] = {&p};
    hipError_t e = hipLaunchCooperativeKernel((void*)fwd_megakernel, dim3(grid_blocks), dim3(512), args, kDynLds, stream);
    if (e != hipSuccess) fprintf(stderr, "cooperative launch failed: %s (grid %d)\n", hipGetErrorString(e), grid_blocks);
}
```

```cpp
#include <hip/hip_runtime.h>
#include <hip/hip_cooperative_groups.h>
#include <cstdio>
namespace cg = cooperative_groups;

#define LAS __attribute__((address_space(3)))
typedef unsigned short bf16_t;
typedef short bf16x8 __attribute__((ext_vector_type(8)));
typedef float f32x4 __attribute__((ext_vector_type(4)));
typedef unsigned u32x4 __attribute__((ext_vector_type(4)));
typedef unsigned u32x2 __attribute__((ext_vector_type(2)));

constexpr int D = 1024, ML = 65536, MC = 2048, MT = ML + MC, DFF = 2816, NMIX = 6912, NMOD = 9216;
constexpr size_t MiB = (size_t)1 << 20;
constexpr size_t WS_X1 = 0, WS_QKV = 132 * MiB, WS_GATE = 528 * MiB, WS_POOL = 656 * MiB, WS_MIXG = 720 * MiB, WS_BG = 976 * MiB,
                 WS_WTGDN = 985 * MiB, WS_WTPOOL = 987 * MiB, WS_WTMIXOUT = 988 * MiB, WS_WTFFN2IN = 990 * MiB, WS_WTFFN2OUT = 1001 * MiB,
                 WS_MODS = 1007 * MiB, WS_WTPOOLW = 1007 * MiB + 512 * 1024, WS_BAR = 1007 * MiB + 768 * 1024, WS_TOTAL = 1008 * MiB;
constexpr size_t WS_HID = WS_QKV, WS_T = WS_QKV, WS_M = WS_QKV + 128 * MiB, WS_POOLPRE = WS_QKV + 256 * MiB, WS_H3 = WS_GATE;
constexpr size_t DO_H = 0, DO_WTFFN1IN = 132 * MiB, DO_WTFFN1OUT = 143 * MiB, DO_SIDE = 149 * MiB, DO_WTMIX = 174 * MiB, DO_OF = 0, DO_OB = 128 * MiB;
constexpr size_t kDynLds = 163840;

struct Params {
    const float *x, *c, *ctx, *c_ctx, *w_ada, *b_ada, *norm1_w, *ffn1_w_in, *ffn1_w_out, *norm2_w, *w_mix_in, *conv_w, *a_log, *dt_bias,
        *gdn_norm_w, *w_gdn_proj, *pool_w, *pool_scale, *w_pool_proj, *w_mix_out, *norm3_w, *ffn2_w_in, *ffn2_w_out, *final_norm_w;
    float* out;
    unsigned char* ws;
};

typedef __bf16 bf16x2_t __attribute__((ext_vector_type(2)));
typedef float f32x2_t __attribute__((ext_vector_type(2)));
__device__ __forceinline__ unsigned cvt_pk_bf16(float lo, float hi) { f32x2_t v = {lo, hi}; bf16x2_t r = __builtin_convertvector(v, bf16x2_t); return __builtin_bit_cast(unsigned, r); }
__device__ __forceinline__ bf16_t f2bf(float f) { return (bf16_t)(cvt_pk_bf16(f, 0.f) & 0xffffu); }
__device__ __forceinline__ float bf2f(bf16_t b) { return __uint_as_float(((unsigned)b) << 16); }
__device__ __forceinline__ float bflo(unsigned u) { return __uint_as_float(u << 16); }
__device__ __forceinline__ float bfhi(unsigned u) { return __uint_as_float(u & 0xffff0000u); }
__device__ __forceinline__ float sigmoid_f(float x) { return __builtin_amdgcn_rcpf(1.f + __builtin_amdgcn_exp2f(-1.4426950408889634f * x)); }
__device__ __forceinline__ float silu_f(float x) { return x * sigmoid_f(x); }
__device__ __forceinline__ float softplus_f(float x) { return x > 20.f ? x : log1pf(__expf(x)); }
__device__ __forceinline__ float wave_sum(float v) {
#pragma unroll
    for (int o = 32; o >= 1; o >>= 1) v += __shfl_xor(v, o);
    return v;
}

namespace pg8 {
constexpr int BM = 256, BK = 64, HALF = 128, HTB = HALF * BK * 2, STAGE_BYTES = 8 * HTB, NXCD = 8, WGM = 8;
__device__ __forceinline__ int lds_byte(int r, int c) { const int st = (r >> 4) * 2 + (c >> 5), rr = r & 15, cc = c & 31, ob = rr * 64 + cc * 2; return st * 1024 + (ob ^ (((ob >> 9) & 1) << 5)); }
__device__ __forceinline__ void stage_rc(int b, int& R, int& C) { const int st = b / 1024, sb = b % 1024, swz = sb ^ (((sb >> 9) & 1) << 5); R = (st >> 1) * 16 + swz / 64; C = (st & 1) * 32 + (swz % 64) / 2; }
__device__ __forceinline__ int perm32(int rho) { const int n = rho >> 4, i = rho & 15; return 8 * (i >> 2) + 4 * n + (i & 3); }
struct Unit { int pm, pn; };
struct Gemm { const bf16_t* A; const bf16_t* Bt; int M, N, K; };
struct StaticOrder {
    int nM, nN, nwg, G, c;
    __device__ void init(int M, int N, int G_, int c_) { nM = M / BM; nN = N / BM; nwg = nM * nN; G = G_; c = c_; }
    __device__ bool next(int i, Unit& u) const {
        const long L = (long)i * G + c; if (L >= nwg) return false;
        int wgid = (int)L; { const int q = nwg / NXCD, r = nwg % NXCD, xcd = wgid % NXCD, off = wgid / NXCD; wgid = (xcd < r ? xcd * (q + 1) : r * (q + 1) + (xcd - r) * q) + off; }
        const int nig = WGM * nN, gid = wgid / nig, fm = gid * WGM, gsz = (nM - fm) < WGM ? (nM - fm) : WGM;
        u.pm = fm + ((wgid % nig) % gsz); u.pn = (wgid % nig) / gsz; return true;
    }
};

template <class Epi>
__device__ __forceinline__ void gemm_phase(LAS unsigned char* lds, const Gemm g, const StaticOrder& S, const Epi& E) {
    int tid_ = threadIdx.x; asm volatile("" : "+v"(tid_));
    const int tid = tid_, wid = __builtin_amdgcn_readfirstlane(tid >> 6), lane = tid & 63, wr = wid >> 2, wc = wid & 3, fr = lane & 15, fq = lane >> 4;
    const int K = g.K, nt = K / BK;
    unsigned voffA[2], voffB[2];
#pragma unroll
    for (int i = 0; i < 2; ++i) { int R, C; stage_rc(tid * 16 + i * 8192, R, C); const int Rb = Epi::PERM ? ((R & ~31) + perm32(R & 31)) : R;
        voffA[i] = (unsigned)(R * K + C) * 2u; voffB[i] = (unsigned)(Rb * K + C) * 2u; }
    const size_t kstep = (size_t)(BK * 2);
    const size_t hstep = (size_t)HALF * K * 2;
    const size_t tstep = 2 * hstep;
    const unsigned ldsw = (unsigned)wid * 1024u;
    const int aoff = lds_byte(wr * 64 + fr, fq * 8), boff = lds_byte(wc * 32 + fr, fq * 8);
#define PG8_SA(b, h) (((b) * 2 + (h)) * HTB)
#define PG8_SB(b, h) ((4 + (b) * 2 + (h)) * HTB)
#define PG8_STAGE(bufoff, gbase, voff) do { _Pragma("unroll") for (int _i = 0; _i < 2; ++_i) \
        __builtin_amdgcn_global_load_lds((const unsigned*)((const char*)(gbase) + (voff)[_i]), (LAS unsigned*)(lds + (bufoff) + ldsw + _i * 8192), 16, 0, 0); } while (0)
#define PG8_LDA(dst, b, h) do { _Pragma("unroll") for (int m = 0; m < 4; ++m) _Pragma("unroll") for (int k = 0; k < 2; ++k) dst[m][k] = *(const LAS bf16x8*)(lds + PG8_SA(b, h) + aoff + m * 2048 + k * 1024); } while (0)
#define PG8_LDB(dst, b, h) do { _Pragma("unroll") for (int n = 0; n < 2; ++n) _Pragma("unroll") for (int k = 0; k < 2; ++k) dst[n][k] = *(const LAS bf16x8*)(lds + PG8_SB(b, h) + boff + n * 2048 + k * 1024); } while (0)
#define PG8_MMA(ai, bj, At, Bt) do { __builtin_amdgcn_s_setprio(1); _Pragma("unroll") for (int m = 0; m < 4; ++m) _Pragma("unroll") for (int n = 0; n < 2; ++n) _Pragma("unroll") for (int k = 0; k < 2; ++k) \
        acc[ai][bj][m][n] = __builtin_amdgcn_mfma_f32_16x16x32_bf16(Bt[n][k], At[m][k], acc[ai][bj][m][n], 0, 0, 0); __builtin_amdgcn_s_setprio(0); } while (0)
#define PG8_WAIT_V(n) asm volatile("s_waitcnt vmcnt(" #n ")" ::: "memory")
#define PG8_WAIT_L(n) asm volatile("s_waitcnt lgkmcnt(" #n ")" ::: "memory")
#define PG8_BAR __builtin_amdgcn_s_barrier()
#define PG8_SCHED __builtin_amdgcn_sched_barrier(0)
    Unit cur, nxt; int ui = 0;
    if (!S.next(0, cur)) return;
    f32x4 acc[2][2][4][2];
#pragma unroll
    for (int a = 0; a < 2; ++a)
#pragma unroll
        for (int b = 0; b < 2; ++b)
#pragma unroll
            for (int m = 0; m < 4; ++m)
#pragma unroll
                for (int n = 0; n < 2; ++n) acc[a][b][m][n] = (f32x4){0.f, 0.f, 0.f, 0.f};
    bf16x8 At[4][2], B0[2][2], B1[2][2];
    const char* cA = (const char*)g.A + (size_t)cur.pm * tstep; const char* cB = (const char*)g.Bt + (size_t)cur.pn * tstep;
    PG8_STAGE(PG8_SB(0, 0), cB, voffB); PG8_STAGE(PG8_SA(0, 0), cA, voffA); PG8_STAGE(PG8_SB(0, 1), cB + hstep, voffB); PG8_STAGE(PG8_SA(0, 1), cA + hstep, voffA);
    if (wr == 1) PG8_BAR;
    PG8_WAIT_V(4); PG8_BAR;
    PG8_STAGE(PG8_SB(1, 0), cB + kstep, voffB); PG8_STAGE(PG8_SA(1, 0), cA + kstep, voffA); PG8_STAGE(PG8_SB(1, 1), cB + hstep + kstep, voffB);
    PG8_WAIT_V(6); PG8_BAR;
    for (;;) {
        const bool has_next = S.next(ui + 1, nxt);
        const char* nA = has_next ? (const char*)g.A + (size_t)nxt.pm * tstep : cA; const char* nB = has_next ? (const char*)g.Bt + (size_t)nxt.pn * tstep : cB;
        for (int t = 0; t < nt; t += 2) {
            const bool last = (t == nt - 2);
            const char* a1 = cA + (size_t)(t + 1) * kstep;
            const char* a2 = last ? nA : cA + (size_t)(t + 2) * kstep; const char* b2 = last ? nB : cB + (size_t)(t + 2) * kstep;
            const char* a3 = a2 + kstep; const char* b3 = b2 + kstep;
            PG8_LDB(B0, 0, 0); PG8_SCHED; PG8_LDA(At, 0, 0); PG8_STAGE(PG8_SA(1, 1), a1 + hstep, voffA);
            PG8_WAIT_L(8); PG8_BAR; PG8_WAIT_L(0); PG8_MMA(0, 0, At, B0); PG8_BAR; PG8_SCHED;
            PG8_LDB(B1, 0, 1); PG8_STAGE(PG8_SB(0, 0), b2, voffB);
            PG8_BAR; PG8_WAIT_L(0); PG8_MMA(0, 1, At, B1); PG8_BAR;
            PG8_LDA(At, 0, 1); PG8_STAGE(PG8_SA(0, 0), a2, voffA);
            PG8_BAR; PG8_WAIT_L(0); PG8_MMA(1, 0, At, B0); PG8_BAR; PG8_SCHED;
            PG8_STAGE(PG8_SB(0, 1), b2 + hstep, voffB);
            PG8_WAIT_V(6); PG8_BAR; PG8_MMA(1, 1, At, B1); PG8_BAR;
            PG8_LDB(B0, 1, 0); PG8_SCHED; PG8_LDA(At, 1, 0); PG8_STAGE(PG8_SA(0, 1), a2 + hstep, voffA);
            PG8_WAIT_L(8); PG8_BAR; PG8_WAIT_L(0); PG8_MMA(0, 0, At, B0); PG8_BAR; PG8_SCHED;
            PG8_LDB(B1, 1, 1); PG8_STAGE(PG8_SB(1, 0), b3, voffB);
            PG8_BAR; PG8_WAIT_L(0); PG8_MMA(0, 1, At, B1); PG8_BAR;
            PG8_LDA(At, 1, 1); PG8_STAGE(PG8_SA(1, 0), a3, voffA);
            PG8_BAR; PG8_WAIT_L(0); PG8_MMA(1, 0, At, B0); PG8_BAR; PG8_SCHED;
            PG8_STAGE(PG8_SB(1, 1), b3 + hstep, voffB);
            PG8_WAIT_V(6); PG8_BAR; PG8_MMA(1, 1, At, B1); PG8_BAR;
        }
        E(acc, cur, wr, wc, fr, fq);
        if (!has_next) break;
#pragma unroll
        for (int a = 0; a < 2; ++a)
#pragma unroll
            for (int b = 0; b < 2; ++b)
#pragma unroll
                for (int m = 0; m < 4; ++m)
#pragma unroll
                    for (int n = 0; n < 2; ++n) acc[a][b][m][n] = (f32x4){0.f, 0.f, 0.f, 0.f};
        cur = nxt; cA = nA; cB = nB; ++ui;
    }
    PG8_WAIT_V(0);
    if (wr == 0) PG8_BAR;
    PG8_BAR;
#undef PG8_SA
#undef PG8_SB
#undef PG8_STAGE
#undef PG8_LDA
#undef PG8_LDB
#undef PG8_MMA
#undef PG8_WAIT_V
#undef PG8_WAIT_L
#undef PG8_BAR
#undef PG8_SCHED
}
}
using pg8::Unit;

struct EpiFfnA {
    static constexpr bool PERM = true;
    bf16_t* H;
    __device__ __forceinline__ void operator()(const f32x4 (&acc)[2][2][4][2], const Unit& u, int wr, int wc, int fr, int fq) const {
        const int row0 = u.pm * 256 + wr * 64 + fr, col0 = u.pn * 128 + wc * 32 + 8 * fq;
#pragma unroll
        for (int ai = 0; ai < 2; ++ai)
#pragma unroll
            for (int m = 0; m < 4; ++m) {
                bf16_t* rowp = H + (size_t)(row0 + ai * 128 + m * 16) * DFF + col0;
                const f32x4 g0 = acc[ai][0][m][0], g1 = acc[ai][0][m][1], u0 = acc[ai][1][m][0], u1 = acc[ai][1][m][1];
                u32x4 o;
                o[0] = cvt_pk_bf16(silu_f(g0[0]) * u0[0], silu_f(g0[1]) * u0[1]); o[1] = cvt_pk_bf16(silu_f(g0[2]) * u0[2], silu_f(g0[3]) * u0[3]);
                o[2] = cvt_pk_bf16(silu_f(g1[0]) * u1[0], silu_f(g1[1]) * u1[1]); o[3] = cvt_pk_bf16(silu_f(g1[2]) * u1[2], silu_f(g1[3]) * u1[3]);
                *(u32x4*)rowp = o;
            }
    }
};
template <bool FIRST> struct EpiFfnB {
    static constexpr bool PERM = false;
    const float* x; const float* ctx; bf16_t* X1; float* out; const float* mods; int gate_i; int pm_off;
    __device__ __forceinline__ void operator()(const f32x4 (&acc)[2][2][4][2], const Unit& u, int wr, int wc, int fr, int fq) const {
        const int pmg = u.pm + pm_off;
        const int row0 = pmg * 256 + wr * 64 + fr, col0 = u.pn * 256 + wc * 32 + 4 * fq;
        const int b = pmg < 256 ? (pmg >> 5) : 8;
        f32x4 gv[2][2];
#pragma unroll
        for (int bj = 0; bj < 2; ++bj)
#pragma unroll
            for (int n = 0; n < 2; ++n) gv[bj][n] = 0.5f * *(const f32x4*)(mods + (size_t)b * NMOD + gate_i * 1024 + col0 + bj * 128 + n * 16);
#pragma unroll
        for (int ai = 0; ai < 2; ++ai)
#pragma unroll
            for (int m = 0; m < 4; ++m) {
                const int row = row0 + ai * 128 + m * 16;
                if (FIRST) {
                    const float* srow = (row < ML ? x + (size_t)row * D : ctx + (size_t)(row - ML) * D) + col0;
                    bf16_t* orow = X1 + (size_t)row * D + col0;
#pragma unroll
                    for (int bj = 0; bj < 2; ++bj)
#pragma unroll
                        for (int n = 0; n < 2; ++n) {
                            const f32x4 s = *(const f32x4*)(srow + bj * 128 + n * 16); const f32x4 r = s + gv[bj][n] * acc[ai][bj][m][n];
                            u32x2 o; o[0] = cvt_pk_bf16(r[0], r[1]); o[1] = cvt_pk_bf16(r[2], r[3]); *(u32x2*)(orow + bj * 128 + n * 16) = o;
                        }
                } else {
                    float* prow = out + (size_t)row * D + col0;
#pragma unroll
                    for (int bj = 0; bj < 2; ++bj)
#pragma unroll
                        for (int n = 0; n < 2; ++n) { f32x4* q = (f32x4*)(prow + bj * 128 + n * 16); *q = *q + gv[bj][n] * acc[ai][bj][m][n]; }
                }
            }
    }
};
template <int KIND>
__device__ __forceinline__ void store_act(const f32x4 (&acc)[2][2][4][2], bf16_t* dst, int ld, int cbase, int row0, int wc, int fq) {
#pragma unroll
    for (int ai = 0; ai < 2; ++ai)
#pragma unroll
        for (int m = 0; m < 4; ++m) {
            const int row = row0 + ai * 128 + m * 16;
#pragma unroll
            for (int bj = 0; bj < 2; ++bj) {
                const int col = cbase + bj * 128 + wc * 32 + 8 * fq;
                f32x4 v0 = acc[ai][bj][m][0], v1 = acc[ai][bj][m][1];
                if (KIND == 0) {
#pragma unroll
                    for (int j = 0; j < 4; ++j) { v0[j] = silu_f(v0[j]); v1[j] = silu_f(v1[j]); }
                } else if (KIND == 2) {
#pragma unroll
                    for (int j = 0; j < 4; ++j) { v0[j] = sigmoid_f(v0[j]); v1[j] = sigmoid_f(v1[j]); }
                }
                u32x4 o; o[0] = cvt_pk_bf16(v0[0], v0[1]); o[1] = cvt_pk_bf16(v0[2], v0[3]); o[2] = cvt_pk_bf16(v1[0], v1[1]); o[3] = cvt_pk_bf16(v1[2], v1[3]);
                *(u32x4*)(dst + (size_t)row * ld + col) = o;
            }
        }
}
struct EpiMix {
    static constexpr bool PERM = true;
    bf16_t *QKV, *SIDE, *GATE, *POOL, *MIXG; float* BG; const float* a_log; const float* dt_bias;
    __device__ __forceinline__ void operator()(const f32x4 (&acc)[2][2][4][2], const Unit& u, int wr, int wc, int fr, int fq) const {
        const int pn = u.pn, row0 = u.pm * 256 + wr * 64 + fr; const bool lat = u.pm < 256;
        if (pn < 12) {
#pragma unroll
            for (int ai = 0; ai < 2; ++ai)
#pragma unroll
                for (int m = 0; m < 4; ++m) {
                    const int row = row0 + ai * 128 + m * 16;
#pragma unroll
                    for (int bj = 0; bj < 2; ++bj) {
                        const int col = pn * 256 + bj * 128 + wc * 32 + 8 * fq;
                        const f32x4 v0 = acc[ai][bj][m][0], v1 = acc[ai][bj][m][1];
                        u32x4 o; o[0] = cvt_pk_bf16(v0[0], v0[1]); o[1] = cvt_pk_bf16(v0[2], v0[3]); o[2] = cvt_pk_bf16(v1[0], v1[1]); o[3] = cvt_pk_bf16(v1[2], v1[3]);
                        *(u32x4*)(QKV + (size_t)row * 3072 + col) = o;
                        if ((m == 0 && fr < 2) || (m == 3 && fr >= 14)) {
                            const int slot = (m == 0) ? fr : fr - 12; const int tile = row >> 6;
                            *(u32x4*)(SIDE + ((size_t)tile * 4 + slot) * 3072 + col) = o;
                        }
                    }
                }
        } else if (pn < 16) {
            if (!lat) return;
            store_act<0>(acc, GATE, 1024, (pn - 12) * 256, row0, wc, fq);
        } else if (pn < 18) {
            if (!lat) return;
            store_act<1>(acc, POOL, 512, (pn - 16) * 256, row0, wc, fq);
        } else if (pn < 26) {
            if (!lat) return;
            store_act<2>(acc, MIXG, 2048, (pn - 18) * 256, row0, wc, fq);
        } else {
            if (wc != 0) return;
            float al[8], db[8]; bool isg = fq >= 2;
#pragma unroll
            for (int j = 0; j < 8; ++j) { const int idx = (8 * fq + j) & 15; al[j] = __expf(a_log[idx]); db[j] = dt_bias[idx]; }
#pragma unroll
            for (int ai = 0; ai < 2; ++ai)
#pragma unroll
                for (int m = 0; m < 4; ++m) {
                    const int row = row0 + ai * 128 + m * 16;
                    f32x4 r[2];
#pragma unroll
                    for (int n = 0; n < 2; ++n)
#pragma unroll
                        for (int j = 0; j < 4; ++j) {
                            const float v = acc[ai][0][m][n][j];
                            r[n][j] = isg ? -al[4 * n + j] * softplus_f(v + db[4 * n + j]) : sigmoid_f(v);
                        }
                    float* bp = BG + (size_t)row * 32 + 8 * fq;
                    *(f32x4*)bp = r[0]; *(f32x4*)(bp + 4) = r[1];
                }
        }
    }
};
template <int MODE> struct EpiMerge {
    static constexpr bool PERM = true;
    const bf16_t* MIXG; const bf16_t* Tin; bf16_t* O;
    __device__ __forceinline__ void operator()(const f32x4 (&acc)[2][2][4][2], const Unit& u, int wr, int wc, int fr, int fq) const {
        const int row0 = u.pm * 256 + wr * 64 + fr;
#pragma unroll
        for (int ai = 0; ai < 2; ++ai)
#pragma unroll
            for (int m = 0; m < 4; ++m) {
                const int row = row0 + ai * 128 + m * 16;
#pragma unroll
                for (int bj = 0; bj < 2; ++bj) {
                    const int col = u.pn * 256 + bj * 128 + wc * 32 + 8 * fq;
                    const u32x4 gq = *(const u32x4*)(MIXG + (size_t)row * 2048 + (MODE ? 1024 : 0) + col);
                    const f32x4 v0 = acc[ai][bj][m][0], v1 = acc[ai][bj][m][1];
                    float r[8];
                    r[0] = bflo(gq[0]) * v0[0]; r[1] = bfhi(gq[0]) * v0[1]; r[2] = bflo(gq[1]) * v0[2]; r[3] = bfhi(gq[1]) * v0[3];
                    r[4] = bflo(gq[2]) * v1[0]; r[5] = bfhi(gq[2]) * v1[1]; r[6] = bflo(gq[3]) * v1[2]; r[7] = bfhi(gq[3]) * v1[3];
                    if (MODE) {
                        const u32x4 tq = *(const u32x4*)(Tin + (size_t)row * D + col);
                        r[0] += bflo(tq[0]); r[1] += bfhi(tq[0]); r[2] += bflo(tq[1]); r[3] += bfhi(tq[1]);
                        r[4] += bflo(tq[2]); r[5] += bfhi(tq[2]); r[6] += bflo(tq[3]); r[7] += bfhi(tq[3]);
                    }
                    u32x4 o; o[0] = cvt_pk_bf16(r[0], r[1]); o[1] = cvt_pk_bf16(r[2], r[3]); o[2] = cvt_pk_bf16(r[4], r[5]); o[3] = cvt_pk_bf16(r[6], r[7]);
                    *(u32x4*)(O + (size_t)row * D + col) = o;
                }
            }
    }
};
struct EpiMixOut {
    static constexpr bool PERM = false;
    const bf16_t* X1; float* out; const float* mods;
    __device__ __forceinline__ void operator()(const f32x4 (&acc)[2][2][4][2], const Unit& u, int wr, int wc, int fr, int fq) const {
        const int row0 = u.pm * 256 + wr * 64 + fr, col0 = u.pn * 256 + wc * 32 + 4 * fq;
        const int b = u.pm >> 5;
        f32x4 gv[2][2];
#pragma unroll
        for (int bj = 0; bj < 2; ++bj)
#pragma unroll
            for (int n = 0; n < 2; ++n) gv[bj][n] = *(const f32x4*)(mods + (size_t)b * NMOD + 5 * 1024 + col0 + bj * 128 + n * 16);
#pragma unroll
        for (int ai = 0; ai < 2; ++ai)
#pragma unroll
            for (int m = 0; m < 4; ++m) {
                const int row = row0 + ai * 128 + m * 16;
#pragma unroll
                for (int bj = 0; bj < 2; ++bj)
#pragma unroll
                    for (int n = 0; n < 2; ++n) {
                        const int col = col0 + bj * 128 + n * 16;
                        const u32x2 xq = *(const u32x2*)(X1 + (size_t)row * D + col);
                        f32x4 r; r[0] = bflo(xq[0]); r[1] = bfhi(xq[0]); r[2] = bflo(xq[1]); r[3] = bfhi(xq[1]);
                        r = r + gv[bj][n] * acc[ai][bj][m][n];
                        *(f32x4*)(out + (size_t)row * D + col) = r;
                    }
            }
    }
};

__device__ __forceinline__ void phase_mods(const Params& p, float* smem, float* mods) {
    const int tid = threadIdx.x;
    for (int i = tid; i < 9 * 1024; i += 512) { const int b = i >> 10, k = i & 1023; const float v = (b < 8) ? p.c[b * 1024 + k] : p.c_ctx[k]; smem[i] = silu_f(v); }
    __syncthreads();
    float* red = smem + 9 * 1024;
    for (int item = blockIdx.x; item < 144; item += gridDim.x) {
        const int cl = tid & 63, kg = tid >> 6, col = item * 64 + cl;
        float acc[9];
#pragma unroll
        for (int b = 0; b < 9; ++b) acc[b] = 0.f;
        for (int k0 = kg * 128; k0 < kg * 128 + 128; k0 += 8) {
            float w[8];
#pragma unroll
            for (int e = 0; e < 8; ++e) w[e] = p.w_ada[(size_t)(k0 + e) * NMOD + col];
#pragma unroll
            for (int b = 0; b < 9; ++b) {
                const f32x4 s0 = *(const f32x4*)(smem + b * 1024 + k0), s1 = *(const f32x4*)(smem + b * 1024 + k0 + 4);
                acc[b] += s0[0] * w[0] + s0[1] * w[1] + s0[2] * w[2] + s0[3] * w[3] + s1[0] * w[4] + s1[1] * w[5] + s1[2] * w[6] + s1[3] * w[7];
            }
        }
#pragma unroll
        for (int b = 0; b < 9; ++b) red[(kg * 9 + b) * 64 + cl] = acc[b];
        __syncthreads();
        for (int o = tid; o < 9 * 64; o += 512) {
            const int b = o >> 6, cc = o & 63; float s = p.b_ada[item * 64 + cc];
            for (int g = 0; g < 8; ++g) s += red[(g * 9 + b) * 64 + cc];
            mods[(size_t)b * NMOD + item * 64 + cc] = s;
        }
        __syncthreads();
    }
}
__device__ __forceinline__ int map_src(int map, int n) {
    if (map == 0) return n;
    if (map == 1) { const int pn = n >> 8, r = n & 255, hid = pn * 128 + (r & 127); return (r < 128) ? hid : DFF + hid; }
    if (n < 3072) return n;
    if (n < 4096) return 3104 + (n - 3072);
    if (n < 4608) return 4128 + (n - 4096);
    if (n < 6656) return 4640 + (n - 4608);
    if (n < 6688) return 3072 + (n - 6656);
    return -1;
}
__device__ __forceinline__ void tconv(const float* src, bf16_t* dst, int K, int N, int Np, int map, int& off, float* tile) {
    const int tk = K / 64, nt = tk * (Np / 64), G = gridDim.x, tid = threadIdx.x;
    const int start = (int)((blockIdx.x + G - (off % G)) % G); off += nt;
    float* tile2 = tile + 64 * 65;
    for (int t = start; t < nt; t += 2 * G) {
        const int t2 = t + G; const bool has2 = t2 < nt;
        const int n0 = (t / tk) * 64, k0 = (t % tk) * 64, n02 = has2 ? (t2 / tk) * 64 : n0, k02 = has2 ? (t2 % tk) * 64 : k0;
        { const int nl = tid & 63, sn = map_src(map, n0 + nl), sn2 = map_src(map, n02 + nl);
          float va[8], vb[8];
#pragma unroll
          for (int i = 0; i < 8; ++i) { const int kl = (tid >> 6) + 8 * i; va[i] = (sn >= 0) ? src[(size_t)(k0 + kl) * N + sn] : 0.f; vb[i] = (sn2 >= 0) ? src[(size_t)(k02 + kl) * N + sn2] : 0.f; }
#pragma unroll
          for (int i = 0; i < 8; ++i) { const int kl = (tid >> 6) + 8 * i; tile[kl * 65 + nl] = va[i]; tile2[kl * 65 + nl] = vb[i]; } }
        __syncthreads();
        { const int kl2 = (tid & 31) * 2;
#pragma unroll
          for (int i = 0; i < 4; ++i) { const int nl = (tid >> 5) + 16 * i;
              *(unsigned*)(dst + (size_t)(n0 + nl) * K + k0 + kl2) = cvt_pk_bf16(tile[kl2 * 65 + nl], tile[(kl2 + 1) * 65 + nl]);
              if (has2) *(unsigned*)(dst + (size_t)(n02 + nl) * K + k02 + kl2) = cvt_pk_bf16(tile2[kl2 * 65 + nl], tile2[(kl2 + 1) * 65 + nl]); } }
        __syncthreads();
    }
}

template <int SRC>
__device__ __forceinline__ void normmod_load(const float* x, const float* ctx, const bf16_t* sb, int row, int lane, float (&v)[16]) {
    if (SRC == 1) {
        const bf16_t* s = sb + (size_t)row * D + lane * 4;
#pragma unroll
        for (int i = 0; i < 4; ++i) { const u32x2 q = *(const u32x2*)(s + 256 * i); v[4 * i] = bflo(q[0]); v[4 * i + 1] = bfhi(q[0]); v[4 * i + 2] = bflo(q[1]); v[4 * i + 3] = bfhi(q[1]); }
    } else {
        const float* s = ((SRC == 0 && row >= ML) ? ctx + (size_t)(row - ML) * D : x + (size_t)row * D) + lane * 4;
#pragma unroll
        for (int i = 0; i < 4; ++i) { const f32x4 q = *(const f32x4*)(s + 256 * i); v[4 * i] = q[0]; v[4 * i + 1] = q[1]; v[4 * i + 2] = q[2]; v[4 * i + 3] = q[3]; }
    }
}
__device__ __forceinline__ void normmod_finish(int row, int lane, const float (&v)[16], bf16_t* dst, const float* nw, const float* mods, int shift_i, int scale_i) {
    const int b = row < ML ? (row >> 13) : 8;
    float ss = 0.f;
#pragma unroll
    for (int i = 0; i < 16; ++i) ss += v[i] * v[i];
    ss = wave_sum(ss);
    const float rstd = rsqrtf(ss * (1.f / 1024.f) + 1e-6f);
    const float* mb = mods + (size_t)b * NMOD;
#pragma unroll
    for (int i = 0; i < 4; ++i) {
        const int col = lane * 4 + 256 * i;
        const f32x4 w = *(const f32x4*)(nw + col), sc = *(const f32x4*)(mb + scale_i * 1024 + col), sh = *(const f32x4*)(mb + shift_i * 1024 + col);
        float y[4];
#pragma unroll
        for (int j = 0; j < 4; ++j) y[j] = v[4 * i + j] * rstd * w[j] * (1.f + sc[j]) + sh[j];
        u32x2 o; o[0] = cvt_pk_bf16(y[0], y[1]); o[1] = cvt_pk_bf16(y[2], y[3]);
        *(u32x2*)(dst + (size_t)row * D + col) = o;
    }
}
template <int SRC>
__device__ __forceinline__ void phase_normmod(const float* x, const float* ctx, const bf16_t* sb, bf16_t* dst, const float* nw, const float* mods, int shift_i, int scale_i, int nrows, int row_begin, int wg, int nwg) {
    const int wave = threadIdx.x >> 6, lane = threadIdx.x & 63, step = nwg * 8;
    for (int row = row_begin + wg * 8 + wave; row < nrows; row += 2 * step) {
        const int rowb = row + step; const bool hasb = rowb < nrows;
        float va[16], vb[16];
        normmod_load<SRC>(x, ctx, sb, row, lane, va);
        if (hasb) normmod_load<SRC>(x, ctx, sb, rowb, lane, vb);
        normmod_finish(row, lane, va, dst, nw, mods, shift_i, scale_i);
        if (hasb) normmod_finish(rowb, lane, vb, dst, nw, mods, shift_i, scale_i);
    }
}
__device__ __forceinline__ void phase_final_norm(float* out, const float* w) {
    const int wave = threadIdx.x >> 6, lane = threadIdx.x & 63, step = gridDim.x * 8;
    for (int row = blockIdx.x * 8 + wave; row < ML; row += 2 * step) {
        float* s0 = out + (size_t)row * D + lane * 4; float* s1 = out + (size_t)((row + step < ML) ? row + step : row) * D + lane * 4;
        f32x4 q0[4], q1[4]; float ss0 = 0.f, ss1 = 0.f;
#pragma unroll
        for (int i = 0; i < 4; ++i) { q0[i] = *(const f32x4*)(s0 + 256 * i); q1[i] = *(const f32x4*)(s1 + 256 * i); }
#pragma unroll
        for (int i = 0; i < 4; ++i) { ss0 += q0[i][0] * q0[i][0] + q0[i][1] * q0[i][1] + q0[i][2] * q0[i][2] + q0[i][3] * q0[i][3]; ss1 += q1[i][0] * q1[i][0] + q1[i][1] * q1[i][1] + q1[i][2] * q1[i][2] + q1[i][3] * q1[i][3]; }
        ss0 = wave_sum(ss0); ss1 = wave_sum(ss1);
        const float r0 = rsqrtf(ss0 * (1.f / 1024.f) + 1e-6f), r1 = rsqrtf(ss1 * (1.f / 1024.f) + 1e-6f);
#pragma unroll
        for (int i = 0; i < 4; ++i) { const f32x4 ww = *(const f32x4*)(w + lane * 4 + 256 * i); *(f32x4*)(s0 + 256 * i) = q0[i] * r0 * ww; *(f32x4*)(s1 + 256 * i) = q1[i] * r1 * ww; }
    }
}

__device__ __forceinline__ void phase_conv(const Params& p, bf16_t* QKV, const bf16_t* SIDE, float* BG) {
    const int tid = threadIdx.x, rg = tid >> 6, cp = tid & 63;
    constexpr int NITEMS = (MT / 64) * 24;
    unsigned qn[12]; f32x2_t wn[5];
#define CONV_LOAD(ITEM) do { const int tile_ = (ITEM) / 24, cgp_ = (ITEM) % 24, t0_ = tile_ * 64, ch_ = cgp_ * 128 + cp * 2; \
        const bool first_ = tile_ < 1024 ? ((tile_ & 127) == 0) : (((tile_ - 1024) & 3) == 0); \
        const bool last_ = tile_ < 1024 ? ((tile_ & 127) == 127) : (((tile_ - 1024) & 3) == 3); \
        _Pragma("unroll") for (int i = 0; i < 12; ++i) { const int lr = rg * 8 - 2 + i; unsigned q = 0u; \
            if (lr >= 0 && lr < 64) q = *(const unsigned*)(QKV + (size_t)(t0_ + lr) * 3072 + ch_); \
            else if (lr < 0) { if (!first_) q = *(const unsigned*)(SIDE + ((size_t)(tile_ - 1) * 4 + (4 + lr)) * 3072 + ch_); } \
            else { if (!last_) q = *(const unsigned*)(SIDE + ((size_t)(tile_ + 1) * 4 + (lr - 64)) * 3072 + ch_); } \
            qn[i] = q; } \
        _Pragma("unroll") for (int k = 0; k < 5; ++k) wn[k] = *(const f32x2_t*)(p.conv_w + k * 3072 + ch_); } while (0)
    int item = blockIdx.x;
    if (item < NITEMS) CONV_LOAD(item);
    bool firstiter = true;
    for (; item < NITEMS; item += gridDim.x) {
        const int tile = item / 24, cgp = item % 24, t0 = tile * 64, ch = cgp * 128 + cp * 2;
        if (firstiter) asm volatile("s_waitcnt vmcnt(0)" ::: "memory"); else asm volatile("s_waitcnt vmcnt(8)" ::: "memory");
        firstiter = false;
        f32x2_t rr[12], wk[5];
#pragma unroll
        for (int i = 0; i < 12; ++i) { rr[i][0] = bflo(qn[i]); rr[i][1] = bfhi(qn[i]); }
#pragma unroll
        for (int k = 0; k < 5; ++k) wk[k] = wn[k];
        asm volatile("" ::: "memory");
        __syncthreads();
        if (item + (int)gridDim.x < NITEMS) CONV_LOAD(item + (int)gridDim.x);
        const float post = cgp < 8 ? 0.08838834764831845f : 1.f;
        f32x2_t y[8]; float ssq[8];
#pragma unroll
        for (int r = 0; r < 8; ++r) {
            f32x2_t acc = wk[0] * rr[r];
#pragma unroll
            for (int k = 1; k < 5; ++k) acc = acc + wk[k] * rr[r + k];
            const f32x2_t ne = acc * -1.4426950408889634f;
            f32x2_t d; d[0] = __builtin_amdgcn_exp2f(ne[0]); d[1] = __builtin_amdgcn_exp2f(ne[1]);
            d = d + 1.0f;
            f32x2_t rc; rc[0] = __builtin_amdgcn_rcpf(d[0]); rc[1] = __builtin_amdgcn_rcpf(d[1]);
            y[r] = acc * rc;
            const f32x2_t sq = y[r] * y[r];
            ssq[r] = sq[0] + sq[1];
        }
        if (cgp < 16) {
            const bool b0 = (cp & 1) != 0, b1 = (cp & 2) != 0, b2 = (cp & 4) != 0;
            float t4[4], t2[2], t1;
#pragma unroll
            for (int i = 0; i < 4; ++i) { const float keep = b0 ? ssq[i + 4] : ssq[i], send = b0 ? ssq[i] : ssq[i + 4]; t4[i] = keep + __shfl_xor(send, 1); }
#pragma unroll
            for (int i = 0; i < 2; ++i) { const float keep = b1 ? t4[i + 2] : t4[i], send = b1 ? t4[i] : t4[i + 2]; t2[i] = keep + __shfl_xor(send, 2); }
            { const float keep = b2 ? t2[1] : t2[0], send = b2 ? t2[0] : t2[1]; t1 = keep + __shfl_xor(send, 4); }
            t1 += __shfl_xor(t1, 8); t1 += __shfl_xor(t1, 16); t1 += __shfl_xor(t1, 32);
#pragma unroll
            for (int r = 0; r < 8; ++r) {
                const float tot = __int_as_float(__builtin_amdgcn_readlane(__float_as_int(t1), ((r >> 2) & 1) | (((r >> 1) & 1) << 1) | ((r & 1) << 2)));
                const float sc = rsqrtf(tot + 1e-6f) * post;
                y[r] = y[r] * sc;
            }
        }
#pragma unroll
        for (int r = 0; r < 8; ++r) *(unsigned*)(QKV + (size_t)(t0 + rg * 8 + r) * 3072 + ch) = cvt_pk_bf16(y[r][0], y[r][1]);
    }
#undef CONV_LOAD
    __syncthreads();
    { const int wave = tid >> 6, lane = tid & 63;
      for (int chunk = blockIdx.x * 8 + wave; chunk < MT / 64; chunk += gridDim.x * 8) {
          float* row = BG + ((size_t)chunk * 64 + lane) * 32 + 16;
          f32x4 g[4];
#pragma unroll
          for (int q = 0; q < 4; ++q) g[q] = *(const f32x4*)(row + 4 * q);
#pragma unroll
          for (int o = 1; o < 64; o <<= 1) {
#pragma unroll
              for (int q = 0; q < 4; ++q)
#pragma unroll
                  for (int e = 0; e < 4; ++e) {
                      const float up = __shfl_up(g[q][e], o), dn = __shfl_down(g[q][e], o);
                      if (q < 2) { if (lane >= o) g[q][e] += up; } else { if (lane + o < 64) g[q][e] += dn; }
                  }
          }
#pragma unroll
          for (int q = 0; q < 4; ++q) *(f32x4*)(row + 4 * q) = g[q];
      } }
}

template <int K>
__device__ __forceinline__ f32x4 mma_tile(const bf16_t* A, int lda, int row0, const bf16_t* Bt, int ldb, int col0, int lane) {
    f32x4 acc = {0.f, 0.f, 0.f, 0.f};
    const bf16_t* ap = A + (row0 + (lane & 15)) * lda + 8 * (lane >> 4);
    const bf16_t* bp = Bt + (col0 + (lane & 15)) * ldb + 8 * (lane >> 4);
#pragma unroll
    for (int k0 = 0; k0 < K; k0 += 32) acc = __builtin_amdgcn_mfma_f32_16x16x32_bf16(*(const bf16x8*)(ap + k0), *(const bf16x8*)(bp + k0), acc, 0, 0, 0);
    return acc;
}
constexpr int G_K = 0, G_KT = 17408, G_Q = 35840, G_V = 53248, G_ST = 61440, G_TB = 78848, G_AQK = 88064, G_NT = 97280, G_MROW = 106496, G_MT = 115712,
              G_PROW = 124928, G_RT = 134144, G_DINV = 143360, G_DINVT = 145408, G_M2T = 147456, G_DL = 147968, G_VEC = 152064, G_OS = 154112;
constexpr int G_VNT = G_MROW, G_VDT = G_MT;

__device__ __forceinline__ bf16x8 ld_frag_half(const bf16_t* p, int lq) {
    bf16x8 z = {0, 0, 0, 0, 0, 0, 0, 0};
    return lq < 2 ? *(const bf16x8*)p : z;
}

__device__ __forceinline__ void phase_gdn(unsigned char* sm, const bf16_t* QKV, const float* BG, bf16_t* OF, bf16_t* OB) {
    const int tid0 = threadIdx.x, wave = __builtin_amdgcn_readfirstlane(tid0 >> 6);
    bf16_t* Ks = (bf16_t*)(sm + G_K); bf16_t* KTs = (bf16_t*)(sm + G_KT); bf16_t* Qs = (bf16_t*)(sm + G_Q); bf16_t* Vs = (bf16_t*)(sm + G_V);
    bf16_t* STs = (bf16_t*)(sm + G_ST); bf16_t* TBs = (bf16_t*)(sm + G_TB); bf16_t* AQs = (bf16_t*)(sm + G_AQK);
    bf16_t* NTs = (bf16_t*)(sm + G_NT); bf16_t* MROW = (bf16_t*)(sm + G_MROW); bf16_t* MTs = (bf16_t*)(sm + G_MT); bf16_t* PROW = (bf16_t*)(sm + G_PROW);
    bf16_t* DINV = (bf16_t*)(sm + G_DINV); bf16_t* DINVT = (bf16_t*)(sm + G_DINVT); bf16_t* M2R = (bf16_t*)(sm + G_M2T);
    float* DL = (float*)(sm + G_DL); float* VEC = (float*)(sm + G_VEC); bf16_t* OSs = (bf16_t*)(sm + G_OS);
    bf16_t* RTs = (bf16_t*)(sm + G_RT); bf16_t* VNs = (bf16_t*)(sm + G_VNT); bf16_t* VDs = (bf16_t*)(sm + G_VDT);
    float* betas = VEC; float* cums = VEC + 64; float* ecums = VEC + 128; float* dds = VEC + 192;
    const int rb = wave >> 1, chh = wave & 1;
    for (int item = blockIdx.x; item < 256; item += gridDim.x) {
        const int half = item & 1, dir = (item >> 1) & 1, h = (item >> 2) & 7, b = item >> 5;
        f32x4 S[4];
#pragma unroll
        for (int n = 0; n < 4; ++n) S[n] = (f32x4){0.f, 0.f, 0.f, 0.f};
        for (int i = tid0; i < 64 * 136 / 2; i += 512) ((unsigned*)STs)[i] = 0u;
        for (int i = tid0; i < 64 * 72 / 2; i += 512) { ((unsigned*)TBs)[i] = 0u; ((unsigned*)AQs)[i] = 0u; }
        bf16_t* O = dir ? OB : OF;
        u32x4 pk0, pk1, pq0, pq1, pv; float pbeta = 0.f, pg = 0.f;
#define GDN_TOK(ci, i) ((ci) < 4 ? (ML + b * 256 + (dir ? 255 - 64 * (ci) - (i) : 64 * (ci) + (i))) : (b * 8192 + (dir ? 8191 - 64 * ((ci) - 4) - (i) : 64 * ((ci) - 4) + (i))))
#define GDN_ISSUE(ci) do { \
            { const size_t ta = (size_t)GDN_TOK(ci, lane) * 3072 + 128 * h + 16 * wave; \
              pk0 = *(const u32x4*)(QKV + ta + 1024); pk1 = *(const u32x4*)(QKV + ta + 1024 + 8); \
              pq0 = *(const u32x4*)(QKV + ta); pq1 = *(const u32x4*)(QKV + ta + 8); \
              pv = *(const u32x4*)(QKV + (size_t)GDN_TOK(ci, lane) * 3072 + 2048 + 128 * h + 64 * half + 8 * wave); } \
            if (wave == 0) { const size_t tk = (size_t)GDN_TOK(ci, lane) * 32; pbeta = BG[tk + dir * 8 + h]; pg = BG[tk + 16 + dir * 8 + h]; } } while (0)
        { const int tid = tid0, lane = tid & 63; GDN_ISSUE(0); }
        for (int ci = 0; ci < 132; ++ci) {
            int tid_o = tid0; asm volatile("" : "+v"(tid_o));
            const int tid = tid_o, lane = tid & 63, l15 = lane & 15, lq = lane >> 4;
            { *(u32x4*)(Ks + lane * 136 + 16 * wave) = pk0; *(u32x4*)(Ks + lane * 136 + 16 * wave + 8) = pk1;
              *(u32x4*)(Qs + lane * 136 + 16 * wave) = pq0; *(u32x4*)(Qs + lane * 136 + 16 * wave + 8) = pq1;
#pragma unroll
              for (int e = 0; e < 4; ++e) {
                  KTs[(16 * wave + 2 * e) * 72 + lane] = (bf16_t)(pk0[e] & 0xffffu); KTs[(16 * wave + 2 * e + 1) * 72 + lane] = (bf16_t)(pk0[e] >> 16);
                  KTs[(16 * wave + 8 + 2 * e) * 72 + lane] = (bf16_t)(pk1[e] & 0xffffu); KTs[(16 * wave + 8 + 2 * e + 1) * 72 + lane] = (bf16_t)(pk1[e] >> 16);
              }
              *(u32x4*)(Vs + lane * 64 + 8 * wave) = pv; }
            if (wave == 0) {
                const float c = pg;
                const float cl = __shfl(c, 63);
                betas[lane] = pbeta; cums[lane] = c; ecums[lane] = __expf(c); dds[lane] = __expf(cl - c);
                if (lane == 63) VEC[256] = __expf(c);
            }
            __syncthreads();
            if (ci >= 5) { const int orow = tid >> 3, opc = tid & 7; *(u32x4*)(O + (size_t)GDN_TOK(ci - 1, orow) * 1024 + 128 * h + 64 * half + 8 * opc) = *(const u32x4*)(OSs + orow * 72 + 8 * opc); }
            if (ci + 1 < 132) GDN_ISSUE(ci + 1);
#pragma unroll
            for (int n = 0; n < 2; ++n) {
                const int col0 = 32 * chh + 16 * n;
                const f32x4 KS = mma_tile<128>(Ks, 136, 16 * rb, STs, 136, col0, lane);
                const int c = col0 + l15, i0 = 16 * rb + 4 * lq;
                float r[4];
                const f32x4 b4 = *(const f32x4*)(betas + i0), e4 = *(const f32x4*)(ecums + i0);
#pragma unroll
                for (int q = 0; q < 4; ++q) { const int i = i0 + q; r[q] = b4[q] * (bf2f(Vs[i * 64 + c]) - e4[q] * KS[q]); }
                u32x2 o; o[0] = cvt_pk_bf16(r[0], r[1]); o[1] = cvt_pk_bf16(r[2], r[3]);
                *(u32x2*)(RTs + c * 72 + i0) = o;
            }
            {
                const int tabv = (wave < 4) ? (wave | wave << 2)
                               : (wave == 4) ? (1 | 0 << 2 | 1 << 4 | 2 << 5 | 0 << 7) : (wave == 5) ? (2 | 1 << 2) : (wave == 6) ? (3 | 0 << 2 | 1 << 4 | 3 << 5 | 1 << 7) : (3 | 2 << 2);
                const int ntile = 1 + ((tabv >> 4) & 1);
                for (int tix = 0; tix < ntile; ++tix) {
                    const int trb = tix ? ((tabv >> 5) & 3) : (tabv & 3), tcb = tix ? ((tabv >> 7) & 3) : ((tabv >> 2) & 3), col0 = 16 * tcb;
                    const f32x4 P = mma_tile<128>(Ks, 136, 16 * trb, Ks, 136, col0, lane);
                    const f32x4 P2 = mma_tile<128>(Qs, 136, 16 * trb, Ks, 136, col0, lane);
                    const int j = col0 + l15; const float cj = cums[j];
                    const f32x4 ci4 = *(const f32x4*)(cums + 16 * trb + 4 * lq), bi4 = *(const f32x4*)(betas + 16 * trb + 4 * lq);
                    float lv[4];
                    if (tcb == trb) {
#pragma unroll
                        for (int r = 0; r < 4; ++r) {
                            const int i = 16 * trb + 4 * lq + r;
                            const float dec = (i >= j) ? __expf(ci4[r] - cj) : 0.f;
                            lv[r] = (i > j) ? bi4[r] * P[r] * dec : 0.f;
                            AQs[i * 72 + j] = f2bf(P2[r] * dec);
                        }
                    } else {
#pragma unroll
                        for (int r = 0; r < 4; ++r) {
                            const int i = 16 * trb + 4 * lq + r;
                            const float dec = __expf(ci4[r] - cj);
                            lv[r] = bi4[r] * P[r] * dec;
                            AQs[i * 72 + j] = f2bf(P2[r] * dec);
                        }
                    }
                    if (tcb == trb) {
                        *(f32x4*)(DL + trb * 256 + l15 * 16 + 4 * lq) = (f32x4){lv[0], lv[1], lv[2], lv[3]};
                        __builtin_amdgcn_fence(__ATOMIC_RELEASE, "wavefront"); __builtin_amdgcn_wave_barrier(); __builtin_amdgcn_fence(__ATOMIC_ACQUIRE, "wavefront");
                        if (lane < 16) {
                            const int blk = trb, c = lane;
                            const float* dl = DL + blk * 256;
                            f32x2_t sp[8];
#pragma unroll
                            for (int k = 0; k < 8; ++k) { sp[k][0] = (2 * k == c) ? 1.f : 0.f; sp[k][1] = (2 * k + 1 == c) ? 1.f : 0.f; }
#pragma unroll
                            for (int j = 0; j < 15; ++j) {
                                const float xj = sp[j >> 1][j & 1];
                                const f32x2_t xj2 = {xj, xj};
                                if ((j & 1) == 0) sp[j >> 1][1] -= dl[j * 16 + j + 1] * xj;
#pragma unroll
                                for (int k = (j >> 1) + 1; k < 8; ++k) { const f32x2_t l2 = *(const f32x2_t*)(dl + j * 16 + 2 * k); sp[k] = sp[k] - l2 * xj2; }
                            }
#pragma unroll
                            for (int i = 0; i < 16; ++i) DINV[blk * 256 + i * 16 + c] = f2bf(sp[i >> 1][i & 1]);
                            u32x4 t0, t1;
#pragma unroll
                            for (int e = 0; e < 4; ++e) { t0[e] = cvt_pk_bf16(sp[e][0], sp[e][1]); t1[e] = cvt_pk_bf16(sp[4 + e][0], sp[4 + e][1]); }
                            *(u32x4*)(DINVT + blk * 256 + c * 16) = t0; *(u32x4*)(DINVT + blk * 256 + c * 16 + 8) = t1;
                        }
                    } else {
                        u32x2 o; o[0] = cvt_pk_bf16(lv[0], lv[1]); o[1] = cvt_pk_bf16(lv[2], lv[3]);
                        *(u32x2*)(NTs + (col0 + l15) * 72 + 16 * trb + 4 * lq) = o;
                    }
                }
            }
            __syncthreads();
            f32x4 mreg[2], m2reg[2];
#pragma unroll
            for (int n = 0; n < 2; ++n) {
                const int cb = 2 * chh + n;
                mreg[n] = (f32x4){0.f, 0.f, 0.f, 0.f}; m2reg[n] = (f32x4){0.f, 0.f, 0.f, 0.f};
                if (cb < rb) {
                    const bf16x8 a = ld_frag_half(DINV + rb * 256 + l15 * 16 + 8 * lq, lq);
                    const bf16x8 bq = ld_frag_half(NTs + (16 * cb + l15) * 72 + 16 * rb + 8 * lq, lq);
                    mreg[n] = __builtin_amdgcn_mfma_f32_16x16x32_bf16(a, bq, mreg[n], 0, 0, 0);
#pragma unroll
                    for (int r = 0; r < 4; ++r) MROW[(16 * rb + 4 * lq + r) * 72 + 16 * cb + l15] = f2bf(mreg[n][r]);
                    u32x2 o; o[0] = cvt_pk_bf16(mreg[n][0], mreg[n][1]); o[1] = cvt_pk_bf16(mreg[n][2], mreg[n][3]);
                    *(u32x2*)(MTs + (16 * cb + l15) * 72 + 16 * rb + 4 * lq) = o;
                }
            }
            __syncthreads();
#pragma unroll
            for (int nn = 0; nn < 2; ++nn) {
                const int n = 1 - nn, cb = 2 * chh + n;
                if (cb <= rb) {
                    f32x4 m3 = {0.f, 0.f, 0.f, 0.f};
                    if (rb - cb >= 2) {
                        const int k0 = 16 * (cb + 1); const bool wide = (rb - cb == 3);
                        const bf16x8 z = {0, 0, 0, 0, 0, 0, 0, 0};
                        const bf16x8 a = (wide || lq < 2) ? *(const bf16x8*)(MROW + (16 * rb + l15) * 72 + k0 + 8 * lq) : z;
                        const bf16x8 bq = (wide || lq < 2) ? *(const bf16x8*)(MTs + (16 * cb + l15) * 72 + k0 + 8 * lq) : z;
                        m2reg[n] = __builtin_amdgcn_mfma_f32_16x16x32_bf16(a, bq, m2reg[n], 0, 0, 0);
                        if (rb == 3 && cb == 1) {
#pragma unroll
                            for (int r = 0; r < 4; ++r) M2R[(4 * lq + r) * 16 + l15] = f2bf(m2reg[n][r]);
                            __builtin_amdgcn_fence(__ATOMIC_RELEASE, "wavefront"); __builtin_amdgcn_wave_barrier(); __builtin_amdgcn_fence(__ATOMIC_ACQUIRE, "wavefront");
                        }
                        if (rb == 3 && cb == 0) {
                            const bf16x8 a3 = ld_frag_half(M2R + l15 * 16 + 8 * lq, lq);
                            const bf16x8 b3 = ld_frag_half(MTs + l15 * 72 + 16 + 8 * lq, lq);
                            m3 = __builtin_amdgcn_mfma_f32_16x16x32_bf16(a3, b3, m3, 0, 0, 0);
                        }
                    }
#pragma unroll
                    for (int r = 0; r < 4; ++r) {
                        const float idv = (cb == rb && (4 * lq + r) == l15) ? 1.f : 0.f;
                        PROW[(16 * rb + 4 * lq + r) * 72 + 16 * cb + l15] = f2bf(idv + m2reg[n][r] - mreg[n][r] - m3[r]);
                    }
                    __builtin_amdgcn_fence(__ATOMIC_RELEASE, "wavefront"); __builtin_amdgcn_wave_barrier(); __builtin_amdgcn_fence(__ATOMIC_ACQUIRE, "wavefront");
                    const bf16x8 a = ld_frag_half(PROW + (16 * rb + l15) * 72 + 16 * cb + 8 * lq, lq);
                    const bf16x8 bq = ld_frag_half(DINVT + cb * 256 + l15 * 16 + 8 * lq, lq);
                    f32x4 t = {0.f, 0.f, 0.f, 0.f};
                    t = __builtin_amdgcn_mfma_f32_16x16x32_bf16(a, bq, t, 0, 0, 0);
#pragma unroll
                    for (int r = 0; r < 4; ++r) TBs[(16 * rb + 4 * lq + r) * 72 + 16 * cb + l15] = f2bf(t[r]);
                }
            }
            __syncthreads();
#pragma unroll
            for (int n = 0; n < 2; ++n) {
                const int col0 = 32 * chh + 16 * n;
                const f32x4 VN = mma_tile<64>(TBs, 72, 16 * rb, RTs, 72, col0, lane);
                const int c = col0 + l15, i0 = 16 * rb + 4 * lq;
                u32x2 o; o[0] = cvt_pk_bf16(VN[0], VN[1]); o[1] = cvt_pk_bf16(VN[2], VN[3]);
                *(u32x2*)(VNs + c * 72 + i0) = o;
                const f32x4 d4 = *(const f32x4*)(dds + i0);
                u32x2 o2; o2[0] = cvt_pk_bf16(VN[0] * d4[0], VN[1] * d4[1]); o2[1] = cvt_pk_bf16(VN[2] * d4[2], VN[3] * d4[3]);
                *(u32x2*)(VDs + c * 72 + i0) = o2;
            }
            __syncthreads();
            if (ci >= 4) {
#pragma unroll
                for (int n = 0; n < 2; ++n) {
                    const int col0 = 32 * chh + 16 * n;
                    const f32x4 A1 = mma_tile<128>(Qs, 136, 16 * rb, STs, 136, col0, lane);
                    const f32x4 A2 = mma_tile<64>(AQs, 72, 16 * rb, VNs, 72, col0, lane);
                    const int c = col0 + l15, i0 = 16 * rb + 4 * lq;
                    const f32x4 e4 = *(const f32x4*)(ecums + i0);
#pragma unroll
                    for (int q = 0; q < 4; ++q) { const int i = i0 + q; OSs[i * 72 + c] = f2bf(e4[q] * A1[q] + A2[q]); }
                }
            }
            { const float bl = VEC[256];
#pragma unroll
              for (int n = 0; n < 4; ++n) { const f32x4 A3 = mma_tile<64>(KTs, 72, 16 * wave, VDs, 72, 16 * n, lane); S[n] = S[n] * bl + A3; } }
            __syncthreads();
#pragma unroll
            for (int n = 0; n < 4; ++n) {
                const int c = 16 * n + l15, r0 = 16 * wave + 4 * lq;
                u32x2 o; o[0] = cvt_pk_bf16(S[n][0], S[n][1]); o[1] = cvt_pk_bf16(S[n][2], S[n][3]);
                *(u32x2*)(STs + c * 136 + r0) = o;
            }
        }
        __syncthreads();
        { const int tid = tid0, orow = tid >> 3, opc = tid & 7; *(u32x4*)(O + (size_t)GDN_TOK(131, orow) * 1024 + 128 * h + 64 * half + 8 * opc) = *(const u32x4*)(OSs + orow * 72 + 8 * opc); }
        __syncthreads();
#undef GDN_TOK
#undef GDN_ISSUE
    }
}

__device__ __forceinline__ void phase_pool(const Params& p, unsigned char* sm, const bf16_t* POOL, const bf16_t* WTPOOLW, bf16_t* PP) {
    const int tid = threadIdx.x, wave = tid >> 6, lane = tid & 63;
    float* Vsum = (float*)sm;
    bf16_t* As = (bf16_t*)(sm + 33792);
    const int c = tid >> 3, ch0 = (tid & 7) * 16;
    for (int item = blockIdx.x; item < 8 * 4 * 128; item += gridDim.x) {
        const int r = item & 127, g = (item >> 7) & 3, b = item >> 9;
        const int hw = 1 << g;
        const int rlo = max(r - hw, 0), rhi = min(r + hw, 128);
        float vs[16], xr[16];
#pragma unroll
        for (int e = 0; e < 16; ++e) vs[e] = 0.f;
        { const bf16_t* src = POOL + ((size_t)(b * 8192 + r * 64 + c)) * 512 + g * 128 + ch0;
          const u32x4 a = *(const u32x4*)src, bq = *(const u32x4*)(src + 8);
#pragma unroll
          for (int e = 0; e < 4; ++e) { xr[2 * e] = bflo(a[e]); xr[2 * e + 1] = bfhi(a[e]); xr[8 + 2 * e] = bflo(bq[e]); xr[8 + 2 * e + 1] = bfhi(bq[e]); } }
        for (int rr0 = rlo; rr0 < rhi; rr0 += 4) {
            u32x4 av[4], bv[4];
#pragma unroll
            for (int u = 0; u < 4; ++u) {
                const int rr = min(rr0 + u, rhi - 1);
                const bf16_t* src = POOL + ((size_t)(b * 8192 + rr * 64 + c)) * 512 + g * 128 + ch0;
                av[u] = *(const u32x4*)src; bv[u] = *(const u32x4*)(src + 8);
            }
#pragma unroll
            for (int u = 0; u < 4; ++u) {
                if (rr0 + u < rhi) {
#pragma unroll
                    for (int e = 0; e < 4; ++e) { vs[2 * e] += bflo(av[u][e]); vs[2 * e + 1] += bfhi(av[u][e]); vs[8 + 2 * e] += bflo(bv[u][e]); vs[8 + 2 * e + 1] += bfhi(bv[u][e]); }
                }
            }
        }
#pragma unroll
        for (int e = 0; e < 4; ++e) *(f32x4*)(Vsum + c * 132 + ch0 + 4 * e) = (f32x4){vs[4 * e], vs[4 * e + 1], vs[4 * e + 2], vs[4 * e + 3]};
        __syncthreads();
        const int clo = max(c - hw, 0), chi = min(c + hw, 64);
        float hs[16];
#pragma unroll
        for (int e = 0; e < 16; ++e) hs[e] = 0.f;
        for (int cc = clo; cc < chi; ++cc) {
#pragma unroll
            for (int e = 0; e < 4; ++e) { const f32x4 q = *(const f32x4*)(Vsum + cc * 132 + ch0 + 4 * e); hs[4 * e] += q[0]; hs[4 * e + 1] += q[1]; hs[4 * e + 2] += q[2]; hs[4 * e + 3] += q[3]; }
        }
        const float inv = 1.f / (float)((rhi - rlo) * (chi - clo));
        u32x4 o0, o1;
#pragma unroll
        for (int e = 0; e < 4; ++e) { o0[e] = cvt_pk_bf16(hs[2 * e] * inv - xr[2 * e], hs[2 * e + 1] * inv - xr[2 * e + 1]); o1[e] = cvt_pk_bf16(hs[8 + 2 * e] * inv - xr[8 + 2 * e], hs[8 + 2 * e + 1] * inv - xr[8 + 2 * e + 1]); }
        *(u32x4*)(As + c * 136 + ch0) = o0; *(u32x4*)(As + c * 136 + ch0 + 8) = o1;
        __syncthreads();
        const bf16_t* Bt = WTPOOLW + g * 16384 + (16 * wave + (lane & 15)) * 128 + 8 * (lane >> 4);
        bf16x8 bf[4];
#pragma unroll
        for (int ks = 0; ks < 4; ++ks) bf[ks] = *(const bf16x8*)(Bt + 32 * ks);
        const int e = 16 * wave + (lane & 15); const float sc = p.pool_scale[g * 128 + e];
#pragma unroll
        for (int rbk = 0; rbk < 4; ++rbk) {
            f32x4 acc = {0.f, 0.f, 0.f, 0.f};
#pragma unroll
            for (int ks = 0; ks < 4; ++ks) acc = __builtin_amdgcn_mfma_f32_16x16x32_bf16(*(const bf16x8*)(As + (16 * rbk + (lane & 15)) * 136 + 32 * ks + 8 * (lane >> 4)), bf[ks], acc, 0, 0, 0);
#pragma unroll
            for (int q = 0; q < 4; ++q) { const int tok = 16 * rbk + 4 * (lane >> 4) + q; PP[((size_t)(b * 8192 + r * 64 + tok)) * 512 + g * 128 + e] = f2bf(acc[q] * sc); }
        }
        __syncthreads();
    }
}

__device__ __forceinline__ void onorm_item(const Params& p, bf16_t* OF, size_t idx, const u32x4 a, const u32x4 bq, const u32x4 gq) {
    const size_t off = idx * 8; const int c8 = (int)(idx & 127) * 8;
    float o[8], ss = 0.f;
#pragma unroll
    for (int e = 0; e < 4; ++e) { o[2 * e] = bflo(a[e]) + bflo(bq[e]); o[2 * e + 1] = bfhi(a[e]) + bfhi(bq[e]); }
#pragma unroll
    for (int e = 0; e < 8; ++e) ss += o[e] * o[e];
    ss += __shfl_xor(ss, 1); ss += __shfl_xor(ss, 2); ss += __shfl_xor(ss, 4); ss += __shfl_xor(ss, 8);
    const float rstd = rsqrtf(ss * (1.f / 128.f) + 1e-6f);
    const f32x4 w0 = *(const f32x4*)(p.gdn_norm_w + (c8 & 127)), w1 = *(const f32x4*)(p.gdn_norm_w + (c8 & 127) + 4);
    u32x4 r;
    r[0] = cvt_pk_bf16(o[0] * rstd * w0[0] * bflo(gq[0]), o[1] * rstd * w0[1] * bfhi(gq[0]));
    r[1] = cvt_pk_bf16(o[2] * rstd * w0[2] * bflo(gq[1]), o[3] * rstd * w0[3] * bfhi(gq[1]));
    r[2] = cvt_pk_bf16(o[4] * rstd * w1[0] * bflo(gq[2]), o[5] * rstd * w1[1] * bfhi(gq[2]));
    r[3] = cvt_pk_bf16(o[6] * rstd * w1[2] * bflo(gq[3]), o[7] * rstd * w1[3] * bfhi(gq[3]));
    *(u32x4*)(OF + off) = r;
}
__device__ __forceinline__ void phase_onorm(const Params& p, bf16_t* OF, const bf16_t* OB, const bf16_t* GATE) {
    const size_t nthr = (size_t)gridDim.x * 512, total = (size_t)ML * 128;
    for (size_t idx = (size_t)blockIdx.x * 512 + threadIdx.x; idx < total; idx += 2 * nthr) {
        const size_t idx2 = (idx + nthr < total) ? idx + nthr : idx;
        const u32x4 a0 = *(const u32x4*)(OF + idx * 8), b0 = *(const u32x4*)(OB + idx * 8), g0 = *(const u32x4*)(GATE + idx * 8);
        const u32x4 a1 = *(const u32x4*)(OF + idx2 * 8), b1 = *(const u32x4*)(OB + idx2 * 8), g1 = *(const u32x4*)(GATE + idx2 * 8);
        onorm_item(p, OF, idx, a0, b0, g0);
        if (idx2 != idx) onorm_item(p, OF, idx2, a1, b1, g1);
    }
}

#define XB_TMO      128
#define XB_XCNT(j)  (256  + 64 * (j))
#define XB_XSUB(j)  (1280 + 64 * (j))
#define XB_XGEN(j)  (2304 + 64 * (j))
#define XB_TOP      3328
#define XB_TOPGEN   3392
#define XCD_BAR_WORDS 3456
#define XB_SPIN_CAP (1u << 18)
__device__ __forceinline__ unsigned xb_ld(unsigned* p)              { return __hip_atomic_load(p, __ATOMIC_RELAXED, __HIP_MEMORY_SCOPE_AGENT); }
__device__ __forceinline__ unsigned xb_add(unsigned* p, unsigned v) { return __hip_atomic_fetch_add(p, v, __ATOMIC_RELAXED, __HIP_MEMORY_SCOPE_AGENT); }
__device__ __forceinline__ unsigned xb_xcc_id() { return (unsigned)__builtin_amdgcn_s_getreg((3 << 11) | 20) & 0xFu; }
#define XB_SPIN(cond, bar) do { unsigned _sp = 0; while (cond) { __builtin_amdgcn_s_sleep(1); \
    if ((++_sp & 255u) == 0u) { if (xb_ld(&(bar)[XB_TMO])) break; if (_sp > XB_SPIN_CAP) { atomicAdd(&(bar)[XB_TMO], 1u); break; } } } } while (0)
struct XcdBarrier { unsigned* bar; unsigned x; volatile LAS unsigned* st; };
__device__ __forceinline__ XcdBarrier xcd_barrier_post(unsigned* bar, volatile LAS unsigned* st) {
    XcdBarrier b; b.bar = bar; b.x = xb_xcc_id(); b.st = st;
    if (threadIdx.x == 0) st[2] = xb_add(&bar[XB_XCNT(b.x)], 1u);
    return b;
}
__device__ __forceinline__ void xcd_barrier_complete(unsigned* bar, unsigned x, unsigned& nloc, unsigned& nx) {
    const unsigned G = gridDim.x * gridDim.y * gridDim.z;
    unsigned sum, cnt, mine, sp = 0u;
    for (;;) {
        sum = 0u; cnt = 0u; mine = 0u;
#pragma unroll
        for (unsigned j = 0; j < 16; ++j) { const unsigned c = xb_ld(&bar[XB_XCNT(j)]); sum += c; cnt += (c > 0u) ? 1u : 0u; mine = (j == x) ? c : mine; }
        if (sum == G) break;
        __builtin_amdgcn_s_sleep(1);
        if ((++sp & 255u) == 0u) { if (xb_ld(&bar[XB_TMO])) break; if (sp > XB_SPIN_CAP) { atomicAdd(&bar[XB_TMO], 1u); break; } }
    }
    nloc = mine > 0u ? mine : 1u; nx = cnt > 0u ? cnt : 1u;
}
__device__ __forceinline__ void xcd_barrier(const XcdBarrier& b) {
    asm volatile("s_waitcnt vmcnt(0)" ::: "memory");
    __syncthreads();
    if (threadIdx.x == 0) {
        unsigned* bar = b.bar;
        __builtin_amdgcn_s_waitcnt(0);
        unsigned nloc = b.st[0], nx = b.st[1];
        if (nloc == 0u) { xcd_barrier_complete(bar, b.x, nloc, nx); b.st[0] = nloc; b.st[1] = nx; }
        const unsigned old = xb_add(&bar[XB_XSUB(b.x)], 1u);
        const unsigned gen = old / nloc;
        if (old + 1u == (gen + 1u) * nloc) {
            __builtin_amdgcn_fence(__ATOMIC_RELEASE, "agent");
            asm volatile("s_waitcnt vmcnt(0)" ::: "memory");
            const unsigned og = xb_add(&bar[XB_TOP], 1u);
            const unsigned tg = og / nx;
            if (og + 1u == (tg + 1u) * nx) xb_add(&bar[XB_TOPGEN], 1u);
            else XB_SPIN(xb_ld(&bar[XB_TOPGEN]) == tg, bar);
            __builtin_amdgcn_fence(__ATOMIC_ACQUIRE, "agent");
            xb_add(&bar[XB_XGEN(b.x)], 1u);
            asm volatile("s_waitcnt vmcnt(0)" ::: "memory");
        } else {
            XB_SPIN(xb_ld(&bar[XB_XGEN(b.x)]) == gen, bar);
            __builtin_amdgcn_fence(__ATOMIC_ACQUIRE, "agent");
            asm volatile("s_waitcnt vmcnt(0)" ::: "memory");
        }
    }
    __syncthreads();
}

#define GSYNC() xcd_barrier(xb)
#define GSYNC_CG() do { asm volatile("s_waitcnt vmcnt(0) lgkmcnt(0)" ::: "memory"); grid.sync(); } while (0)
__global__ void __launch_bounds__(512, 2) fwd_megakernel(Params p) {
    extern __shared__ __attribute__((aligned(16))) unsigned char shm[];
    cg::grid_group grid = cg::this_grid();
    LAS unsigned char* lds = (LAS unsigned char*)shm;
    const int G = gridDim.x, bid = blockIdx.x;
    pg8::StaticOrder S;
    volatile LAS unsigned* xb_st = (volatile LAS unsigned*)(lds + (kDynLds - 16));
    if (threadIdx.x == 0) { xb_st[0] = 0u; xb_st[1] = 0u; }
    __syncthreads();
    const XcdBarrier xb = xcd_barrier_post((unsigned*)(p.ws + WS_BAR), xb_st);

    phase_mods(p, (float*)shm, ((float*)((unsigned char*)p.ws + WS_MODS)));
    { int off = 0; float* tile = (float*)shm;
      tconv(p.ffn1_w_in, ((bf16_t*)((unsigned char*)p.out + DO_WTFFN1IN)), 1024, 2 * DFF, 2 * DFF, 1, off, tile);
      tconv(p.ffn1_w_out, ((bf16_t*)((unsigned char*)p.out + DO_WTFFN1OUT)), DFF, 1024, 1024, 0, off, tile);
      tconv(p.w_mix_in, ((bf16_t*)((unsigned char*)p.out + DO_WTMIX)), 1024, 6688, NMIX, 2, off, tile);
      tconv(p.w_gdn_proj, ((bf16_t*)((unsigned char*)p.ws + WS_WTGDN)), 1024, 1024, 1024, 0, off, tile);
      tconv(p.w_pool_proj, ((bf16_t*)((unsigned char*)p.ws + WS_WTPOOL)), 512, 1024, 1024, 0, off, tile);
      tconv(p.w_mix_out, ((bf16_t*)((unsigned char*)p.ws + WS_WTMIXOUT)), 1024, 1024, 1024, 0, off, tile);
      tconv(p.ffn2_w_in, ((bf16_t*)((unsigned char*)p.ws + WS_WTFFN2IN)), 1024, 2 * DFF, 2 * DFF, 1, off, tile);
      tconv(p.ffn2_w_out, ((bf16_t*)((unsigned char*)p.ws + WS_WTFFN2OUT)), DFF, 1024, 1024, 0, off, tile);
      for (int g = 0; g < 4; ++g) tconv(p.pool_w + g * 16384, ((bf16_t*)((unsigned char*)p.ws + WS_WTPOOLW)) + g * 16384, 128, 128, 128, 0, off, tile); }
    GSYNC_CG();
    if (threadIdx.x == 0) {
        unsigned ok = ((unsigned)G % 8u == 0u && xb.x < 8u) ? 1u : 0u;
        for (unsigned j8 = 0; j8 < 8u; ++j8) ok &= (xb_ld(&xb.bar[XB_XCNT(j8)]) == (unsigned)G / 8u) ? 1u : 0u;
        xb_st[3] = ok ? (xb_st[2] * 8u + xb.x) : (unsigned)bid;
    }
    __syncthreads();
    const int cvirt = __builtin_amdgcn_readfirstlane((int)xb_st[3]);
    phase_normmod<0>(p.x, p.ctx, nullptr, ((bf16_t*)((unsigned char*)p.out + DO_H)), p.norm1_w, ((float*)((unsigned char*)p.ws + WS_MODS)), 0, 1, MT, 0, bid, G);
    GSYNC();
    { S.init(MT, 2 * DFF, G, cvirt); pg8::gemm_phase(lds, pg8::Gemm{((bf16_t*)((unsigned char*)p.out + DO_H)), ((bf16_t*)((unsigned char*)p.out + DO_WTFFN1IN)), MT, 2 * DFF, 1024}, S, EpiFfnA{((bf16_t*)((unsigned char*)p.ws + WS_HID))}); }
    GSYNC();
    { S.init(ML, 1024, G, cvirt); pg8::gemm_phase(lds, pg8::Gemm{((bf16_t*)((unsigned char*)p.ws + WS_HID)), ((bf16_t*)((unsigned char*)p.out + DO_WTFFN1OUT)), ML, 1024, DFF}, S, EpiFfnB<true>{p.x, p.ctx, ((bf16_t*)((unsigned char*)p.ws + WS_X1)), nullptr, ((float*)((unsigned char*)p.ws + WS_MODS)), 2, 0}); }
    GSYNC();
    if (cvirt < 32) { S.init(MC, 1024, 32, cvirt); pg8::gemm_phase(lds, pg8::Gemm{((bf16_t*)((unsigned char*)p.ws + WS_HID)) + (size_t)ML * DFF, ((bf16_t*)((unsigned char*)p.out + DO_WTFFN1OUT)), MC, 1024, DFF}, S, EpiFfnB<true>{p.x, p.ctx, ((bf16_t*)((unsigned char*)p.ws + WS_X1)), nullptr, ((float*)((unsigned char*)p.ws + WS_MODS)), 2, 256}); }
    else phase_normmod<1>(nullptr, nullptr, ((bf16_t*)((unsigned char*)p.ws + WS_X1)), ((bf16_t*)((unsigned char*)p.out + DO_H)), p.norm2_w, ((float*)((unsigned char*)p.ws + WS_MODS)), 3, 4, ML, 0, cvirt - 32, G - 32);
    GSYNC();
    phase_normmod<1>(nullptr, nullptr, ((bf16_t*)((unsigned char*)p.ws + WS_X1)), ((bf16_t*)((unsigned char*)p.out + DO_H)), p.norm2_w, ((float*)((unsigned char*)p.ws + WS_MODS)), 3, 4, MT, ML, bid, G);
    GSYNC();
    { S.init(MT, NMIX, G, cvirt); pg8::gemm_phase(lds, pg8::Gemm{((bf16_t*)((unsigned char*)p.out + DO_H)), ((bf16_t*)((unsigned char*)p.out + DO_WTMIX)), MT, NMIX, 1024}, S, EpiMix{((bf16_t*)((unsigned char*)p.ws + WS_QKV)), ((bf16_t*)((unsigned char*)p.out + DO_SIDE)), ((bf16_t*)((unsigned char*)p.ws + WS_GATE)), ((bf16_t*)((unsigned char*)p.ws + WS_POOL)), ((bf16_t*)((unsigned char*)p.ws + WS_MIXG)), ((float*)((unsigned char*)p.ws + WS_BG)), p.a_log, p.dt_bias}); }
    GSYNC();
    phase_conv(p, ((bf16_t*)((unsigned char*)p.ws + WS_QKV)), ((bf16_t*)((unsigned char*)p.out + DO_SIDE)), ((float*)((unsigned char*)p.ws + WS_BG)));
    GSYNC();
    phase_gdn(shm, ((bf16_t*)((unsigned char*)p.ws + WS_QKV)), ((float*)((unsigned char*)p.ws + WS_BG)), ((bf16_t*)((unsigned char*)p.out + DO_OF)), ((bf16_t*)((unsigned char*)p.out + DO_OB)));
    GSYNC();
    phase_pool(p, shm, ((bf16_t*)((unsigned char*)p.ws + WS_POOL)), ((bf16_t*)((unsigned char*)p.ws + WS_WTPOOLW)), ((bf16_t*)((unsigned char*)p.ws + WS_POOLPRE)));
    phase_onorm(p, ((bf16_t*)((unsigned char*)p.out + DO_OF)), ((bf16_t*)((unsigned char*)p.out + DO_OB)), ((bf16_t*)((unsigned char*)p.ws + WS_GATE)));
    GSYNC();
    { S.init(ML, 1024, G, cvirt); pg8::gemm_phase(lds, pg8::Gemm{((bf16_t*)((unsigned char*)p.ws + WS_POOLPRE)), ((bf16_t*)((unsigned char*)p.ws + WS_WTPOOL)), ML, 1024, 512}, S, EpiMerge<0>{((bf16_t*)((unsigned char*)p.ws + WS_MIXG)), nullptr, ((bf16_t*)((unsigned char*)p.ws + WS_T))}); }
    GSYNC();
    { S.init(ML, 1024, G, cvirt); pg8::gemm_phase(lds, pg8::Gemm{((bf16_t*)((unsigned char*)p.out + DO_OF)), ((bf16_t*)((unsigned char*)p.ws + WS_WTGDN)), ML, 1024, 1024}, S, EpiMerge<1>{((bf16_t*)((unsigned char*)p.ws + WS_MIXG)), ((bf16_t*)((unsigned char*)p.ws + WS_T)), ((bf16_t*)((unsigned char*)p.ws + WS_M))}); }
    GSYNC();
    { S.init(ML, 1024, G, cvirt); pg8::gemm_phase(lds, pg8::Gemm{((bf16_t*)((unsigned char*)p.ws + WS_M)), ((bf16_t*)((unsigned char*)p.ws + WS_WTMIXOUT)), ML, 1024, 1024}, S, EpiMixOut{((bf16_t*)((unsigned char*)p.ws + WS_X1)), p.out, ((float*)((unsigned char*)p.ws + WS_MODS))}); }
    GSYNC();
    phase_normmod<2>(p.out, nullptr, nullptr, ((bf16_t*)((unsigned char*)p.ws + WS_H3)), p.norm3_w, ((float*)((unsigned char*)p.ws + WS_MODS)), 6, 7, ML, 0, bid, G);
    GSYNC();
    { S.init(ML, 2 * DFF, G, cvirt); pg8::gemm_phase(lds, pg8::Gemm{((bf16_t*)((unsigned char*)p.ws + WS_H3)), ((bf16_t*)((unsigned char*)p.ws + WS_WTFFN2IN)), ML, 2 * DFF, 1024}, S, EpiFfnA{((bf16_t*)((unsigned char*)p.ws + WS_HID))}); }
    GSYNC();
    { S.init(ML, 1024, G, cvirt); pg8::gemm_phase(lds, pg8::Gemm{((bf16_t*)((unsigned char*)p.ws + WS_HID)), ((bf16_t*)((unsigned char*)p.ws + WS_WTFFN2OUT)), ML, 1024, DFF}, S, EpiFfnB<false>{nullptr, nullptr, nullptr, p.out, ((float*)((unsigned char*)p.ws + WS_MODS)), 8}); }
    GSYNC();
    phase_final_norm(p.out, p.final_norm_w);
}

extern "C" void kernel_launch(void* const* d_in, const int* in_sizes, int n_in, void* d_out, int out_size, void* d_ws, size_t ws_size, hipStream_t stream) {
    static int grid_blocks = 0;
    if (!grid_blocks) {
        hipFuncSetAttribute((const void*)fwd_megakernel, hipFuncAttributeMaxDynamicSharedMemorySize, (int)kDynLds);
        int dev = 0, cus = 0, per_cu = 0;
        hipGetDevice(&dev);
        hipDeviceGetAttribute(&cus, hipDeviceAttributeMultiprocessorCount, dev);
        hipOccupancyMaxActiveBlocksPerMultiprocessor(&per_cu, fwd_megakernel, 512, kDynLds);
        grid_blocks = cus * per_cu;
        if (grid_blocks > 256) grid_blocks = 256;
        if (grid_blocks <= 0) grid_blocks = 256;
    }
    if (ws_size < WS_TOTAL) { fprintf(stderr, "workspace too small: %zu < %zu\n", ws_size, (size_t)WS_TOTAL); return; }
    Params p{};
    const float** pp = (const float**)&p;
    for (int i = 0; i < 24; ++i) pp[i] = (const float*)d_in[i];
    p.out = (float*)d_out; p.ws = (unsigned char*)d_ws;
    (void)hipMemsetAsync((unsigned char*)d_ws + WS_BAR, 0, XCD_BAR_WORDS * 4, stream);
    void* args[] = {&p};
    hipError_t e = hipLaunchCooperativeKernel((void*)fwd_megakernel, dim3(grid_blocks), dim3(512), args, kDynLds, stream);
    if (e != hipSuccess) fprintf(stderr, "cooperative launch failed: %s (grid %d)\n", hipGetErrorString(e), grid_blocks);
}
```

```cpp
#include <hip/hip_runtime.h>
#include <hip/hip_cooperative_groups.h>
#include <cstdio>
namespace cg = cooperative_groups;

#define LAS __attribute__((address_space(3)))
typedef unsigned short bf16_t;
typedef short bf16x8 __attribute__((ext_vector_type(8)));
typedef float f32x4 __attribute__((ext_vector_type(4)));
typedef unsigned u32x4 __attribute__((ext_vector_type(4)));
typedef unsigned u32x2 __attribute__((ext_vector_type(2)));

constexpr int D = 1024, ML = 65536, MC = 2048, MT = ML + MC, DFF = 2816, NMIX = 6912, NMOD = 9216;
constexpr size_t MiB = (size_t)1 << 20;
constexpr size_t WS_X1 = 0, WS_QKV = 132 * MiB, WS_GATE = 528 * MiB, WS_POOL = 656 * MiB, WS_MIXG = 720 * MiB, WS_BG = 976 * MiB,
                 WS_WTGDN = 985 * MiB, WS_WTPOOL = 987 * MiB, WS_WTMIXOUT = 988 * MiB, WS_WTFFN2IN = 990 * MiB, WS_WTFFN2OUT = 1001 * MiB,
                 WS_MODS = 1007 * MiB, WS_WTPOOLW = 1007 * MiB + 512 * 1024, WS_BAR = 1007 * MiB + 768 * 1024, WS_TOTAL = 1008 * MiB;
constexpr size_t WS_HID = WS_QKV, WS_T = WS_QKV, WS_M = WS_QKV + 128 * MiB, WS_POOLPRE = WS_QKV + 256 * MiB, WS_H3 = WS_GATE;
constexpr size_t DO_H = 0, DO_WTFFN1IN = 132 * MiB, DO_WTFFN1OUT = 143 * MiB, DO_SIDE = 149 * MiB, DO_WTMIX = 174 * MiB, DO_OF = 0, DO_OB = 128 * MiB;
constexpr size_t kDynLds = 163840;

struct Params {
    const float *x, *c, *ctx, *c_ctx, *w_ada, *b_ada, *norm1_w, *ffn1_w_in, *ffn1_w_out, *norm2_w, *w_mix_in, *conv_w, *a_log, *dt_bias,
        *gdn_norm_w, *w_gdn_proj, *pool_w, *pool_scale, *w_pool_proj, *w_mix_out, *norm3_w, *ffn2_w_in, *ffn2_w_out, *final_norm_w;
    float* out;
    unsigned char* ws;
};

typedef __bf16 bf16x2_t __attribute__((ext_vector_type(2)));
typedef float f32x2_t __attribute__((ext_vector_type(2)));
__device__ __forceinline__ unsigned cvt_pk_bf16(float lo, float hi) { f32x2_t v = {lo, hi}; bf16x2_t r = __builtin_convertvector(v, bf16x2_t); return __builtin_bit_cast(unsigned, r); }
__device__ __forceinline__ bf16_t f2bf(float f) { return (bf16_t)(cvt_pk_bf16(f, 0.f) & 0xffffu); }
__device__ __forceinline__ float bf2f(bf16_t b) { return __uint_as_float(((unsigned)b) << 16); }
__device__ __forceinline__ float bflo(unsigned u) { return __uint_as_float(u << 16); }
__device__ __forceinline__ float bfhi(unsigned u) { return __uint_as_float(u & 0xffff0000u); }
__device__ __forceinline__ float sigmoid_f(float x) { return __builtin_amdgcn_rcpf(1.f + __builtin_amdgcn_exp2f(-1.4426950408889634f * x)); }
__device__ __forceinline__ float silu_f(float x) { return x * sigmoid_f(x); }
__device__ __forceinline__ float softplus_f(float x) { return x > 20.f ? x : log1pf(__expf(x)); }
__device__ __forceinline__ float wave_sum(float v) {
#pragma unroll
    for (int o = 32; o >= 1; o >>= 1) v += __shfl_xor(v, o);
    return v;
}

namespace pg8 {
constexpr int BM = 256, BK = 64, HALF = 128, HTB = HALF * BK * 2, STAGE_BYTES = 8 * HTB, NXCD = 8, WGM = 8;
__device__ __forceinline__ int lds_byte(int r, int c) { const int st = (r >> 4) * 2 + (c >> 5), rr = r & 15, cc = c & 31, ob = rr * 64 + cc * 2; return st * 1024 + (ob ^ (((ob >> 9) & 1) << 5)); }
__device__ __forceinline__ void stage_rc(int b, int& R, int& C) { const int st = b / 1024, sb = b % 1024, swz = sb ^ (((sb >> 9) & 1) << 5); R = (st >> 1) * 16 + swz / 64; C = (st & 1) * 32 + (swz % 64) / 2; }
__device__ __forceinline__ int perm32(int rho) { const int n = rho >> 4, i = rho & 15; return 8 * (i >> 2) + 4 * n + (i & 3); }
struct Unit { int pm, pn; };
struct Gemm { const bf16_t* A; const bf16_t* Bt; int M, N, K; };
struct StaticOrder {
    int nM, nN, nwg, G, c;
    __device__ void init(int M, int N, int G_, int c_) { nM = M / BM; nN = N / BM; nwg = nM * nN; G = G_; c = c_; }
    __device__ bool next(int i, Unit& u) const {
        const long L = (long)i * G + c; if (L >= nwg) return false;
        int wgid = (int)L; { const int q = nwg / NXCD, r = nwg % NXCD, xcd = wgid % NXCD, off = wgid / NXCD; wgid = (xcd < r ? xcd * (q + 1) : r * (q + 1) + (xcd - r) * q) + off; }
        const int nig = WGM * nN, gid = wgid / nig, fm = gid * WGM, gsz = (nM - fm) < WGM ? (nM - fm) : WGM;
        u.pm = fm + ((wgid % nig) % gsz); u.pn = (wgid % nig) / gsz; return true;
    }
};

template <class Epi>
__device__ __forceinline__ void gemm_phase(LAS unsigned char* lds, const Gemm g, const StaticOrder& S, const Epi& E) {
    int tid_ = threadIdx.x; asm volatile("" : "+v"(tid_));
    const int tid = tid_, wid = __builtin_amdgcn_readfirstlane(tid >> 6), lane = tid & 63, wr = wid >> 2, wc = wid & 3, fr = lane & 15, fq = lane >> 4;
    const int K = g.K, nt = K / BK;
    unsigned voffA[2], voffB[2];
#pragma unroll
    for (int i = 0; i < 2; ++i) { int R, C; stage_rc(tid * 16 + i * 8192, R, C); const int Rb = Epi::PERM ? ((R & ~31) + perm32(R & 31)) : R;
        voffA[i] = (unsigned)(R * K + C) * 2u; voffB[i] = (unsigned)(Rb * K + C) * 2u; }
    const size_t kstep = (size_t)(BK * 2);
    const size_t hstep = (size_t)HALF * K * 2;
    const size_t tstep = 2 * hstep;
    const unsigned ldsw = (unsigned)wid * 1024u;
    const int aoff = lds_byte(wr * 64 + fr, fq * 8), boff = lds_byte(wc * 32 + fr, fq * 8);
#define PG8_SA(b, h) (((b) * 2 + (h)) * HTB)
#define PG8_SB(b, h) ((4 + (b) * 2 + (h)) * HTB)
#define PG8_STAGE(bufoff, gbase, voff) do { _Pragma("unroll") for (int _i = 0; _i < 2; ++_i) \
        __builtin_amdgcn_global_load_lds((const unsigned*)((const char*)(gbase) + (voff)[_i]), (LAS unsigned*)(lds + (bufoff) + ldsw + _i * 8192), 16, 0, 0); } while (0)
#define PG8_LDA(dst, b, h) do { _Pragma("unroll") for (int m = 0; m < 4; ++m) _Pragma("unroll") for (int k = 0; k < 2; ++k) dst[m][k] = *(const LAS bf16x8*)(lds + PG8_SA(b, h) + aoff + m * 2048 + k * 1024); } while (0)
#define PG8_LDB(dst, b, h) do { _Pragma("unroll") for (int n = 0; n < 2; ++n) _Pragma("unroll") for (int k = 0; k < 2; ++k) dst[n][k] = *(const LAS bf16x8*)(lds + PG8_SB(b, h) + boff + n * 2048 + k * 1024); } while (0)
#define PG8_MMA(ai, bj, At, Bt) do { __builtin_amdgcn_s_setprio(1); _Pragma("unroll") for (int m = 0; m < 4; ++m) _Pragma("unroll") for (int n = 0; n < 2; ++n) _Pragma("unroll") for (int k = 0; k < 2; ++k) \
        acc[ai][bj][m][n] = __builtin_amdgcn_mfma_f32_16x16x32_bf16(Bt[n][k], At[m][k], acc[ai][bj][m][n], 0, 0, 0); __builtin_amdgcn_s_setprio(0); } while (0)
#define PG8_WAIT_V(n) asm volatile("s_waitcnt vmcnt(" #n ")" ::: "memory")
#define PG8_WAIT_L(n) asm volatile("s_waitcnt lgkmcnt(" #n ")" ::: "memory")
#define PG8_BAR __builtin_amdgcn_s_barrier()
#define PG8_SCHED __builtin_amdgcn_sched_barrier(0)
    Unit cur, nxt; int ui = 0;
    if (!S.next(0, cur)) return;
    f32x4 acc[2][2][4][2];
#pragma unroll
    for (int a = 0; a < 2; ++a)
#pragma unroll
        for (int b = 0; b < 2; ++b)
#pragma unroll
            for (int m = 0; m < 4; ++m)
#pragma unroll
                for (int n = 0; n < 2; ++n) acc[a][b][m][n] = (f32x4){0.f, 0.f, 0.f, 0.f};
    bf16x8 At[4][2], B0[2][2], B1[2][2];
    const char* cA = (const char*)g.A + (size_t)cur.pm * tstep; const char* cB = (const char*)g.Bt + (size_t)cur.pn * tstep;
    PG8_STAGE(PG8_SB(0, 0), cB, voffB); PG8_STAGE(PG8_SA(0, 0), cA, voffA); PG8_STAGE(PG8_SB(0, 1), cB + hstep, voffB); PG8_STAGE(PG8_SA(0, 1), cA + hstep, voffA);
    if (wr == 1) PG8_BAR;
    PG8_WAIT_V(4); PG8_BAR;
    PG8_STAGE(PG8_SB(1, 0), cB + kstep, voffB); PG8_STAGE(PG8_SA(1, 0), cA + kstep, voffA); PG8_STAGE(PG8_SB(1, 1), cB + hstep + kstep, voffB);
    PG8_WAIT_V(6); PG8_BAR;
    for (;;) {
        const bool has_next = S.next(ui + 1, nxt);
        const char* nA = has_next ? (const char*)g.A + (size_t)nxt.pm * tstep : cA; const char* nB = has_next ? (const char*)g.Bt + (size_t)nxt.pn * tstep : cB;
        for (int t = 0; t < nt; t += 2) {
            const bool last = (t == nt - 2);
            const char* a1 = cA + (size_t)(t + 1) * kstep;
            const char* a2 = last ? nA : cA + (size_t)(t + 2) * kstep; const char* b2 = last ? nB : cB + (size_t)(t + 2) * kstep;
            const char* a3 = a2 + kstep; const char* b3 = b2 + kstep;
            PG8_LDB(B0, 0, 0); PG8_SCHED; PG8_LDA(At, 0, 0); PG8_STAGE(PG8_SA(1, 1), a1 + hstep, voffA);
            PG8_WAIT_L(8); PG8_BAR; PG8_WAIT_L(0); PG8_MMA(0, 0, At, B0); PG8_BAR; PG8_SCHED;
            PG8_LDB(B1, 0, 1); PG8_STAGE(PG8_SB(0, 0), b2, voffB);
            PG8_BAR; PG8_WAIT_L(0); PG8_MMA(0, 1, At, B1); PG8_BAR;
            PG8_LDA(At, 0, 1); PG8_STAGE(PG8_SA(0, 0), a2, voffA);
            PG8_BAR; PG8_WAIT_L(0); PG8_MMA(1, 0, At, B0); PG8_BAR; PG8_SCHED;
            PG8_STAGE(PG8_SB(0, 1), b2 + hstep, voffB);
            PG8_WAIT_V(6); PG8_BAR; PG8_MMA(1, 1, At, B1); PG8_BAR;
            PG8_LDB(B0, 1, 0); PG8_SCHED; PG8_LDA(At, 1, 0); PG8_STAGE(PG8_SA(0, 1), a2 + hstep, voffA);
            PG8_WAIT_L(8); PG8_BAR; PG8_WAIT_L(0); PG8_MMA(0, 0, At, B0); PG8_BAR; PG8_SCHED;
            PG8_LDB(B1, 1, 1); PG8_STAGE(PG8_SB(1, 0), b3, voffB);
            PG8_BAR; PG8_WAIT_L(0); PG8_MMA(0, 1, At, B1); PG8_BAR;
            PG8_LDA(At, 1, 1); PG8_STAGE(PG8_SA(1, 0), a3, voffA);
            PG8_BAR; PG8_WAIT_L(0); PG8_MMA(1, 0, At, B0); PG8_BAR; PG8_SCHED;
            PG8_STAGE(PG8_SB(1, 1), b3 + hstep, voffB);
            PG8_WAIT_V(6); PG8_BAR; PG8_MMA(1, 1, At, B1); PG8_BAR;
        }
        E(acc, cur, wr, wc, fr, fq);
        if (!has_next) break;
#pragma unroll
        for (int a = 0; a < 2; ++a)
#pragma unroll
            for (int b = 0; b < 2; ++b)
#pragma unroll
                for (int m = 0; m < 4; ++m)
#pragma unroll
                    for (int n = 0; n < 2; ++n) acc[a][b][m][n] = (f32x4){0.f, 0.f, 0.f, 0.f};
        cur = nxt; cA = nA; cB = nB; ++ui;
    }
    PG8_WAIT_V(0);
    if (wr == 0) PG8_BAR;
    PG8_BAR;
#undef PG8_SA
#undef PG8_SB
#undef PG8_STAGE
#undef PG8_LDA
#undef PG8_LDB
#undef PG8_MMA
#undef PG8_WAIT_V
#undef PG8_WAIT_L
#undef PG8_BAR
#undef PG8_SCHED
}
}
using pg8::Unit;

struct EpiFfnA {
    static constexpr bool PERM = true;
    bf16_t* H;
    __device__ __forceinline__ void operator()(const f32x4 (&acc)[2][2][4][2], const Unit& u, int wr, int wc, int fr, int fq) const {
        const int row0 = u.pm * 256 + wr * 64 + fr, col0 = u.pn * 128 + wc * 32 + 8 * fq;
#pragma unroll
        for (int ai = 0; ai < 2; ++ai)
#pragma unroll
            for (int m = 0; m < 4; ++m) {
                bf16_t* rowp = H + (size_t)(row0 + ai * 128 + m * 16) * DFF + col0;
                const f32x4 g0 = acc[ai][0][m][0], g1 = acc[ai][0][m][1], u0 = acc[ai][1][m][0], u1 = acc[ai][1][m][1];
                u32x4 o;
                o[0] = cvt_pk_bf16(silu_f(g0[0]) * u0[0], silu_f(g0[1]) * u0[1]); o[1] = cvt_pk_bf16(silu_f(g0[2]) * u0[2], silu_f(g0[3]) * u0[3]);
                o[2] = cvt_pk_bf16(silu_f(g1[0]) * u1[0], silu_f(g1[1]) * u1[1]); o[3] = cvt_pk_bf16(silu_f(g1[2]) * u1[2], silu_f(g1[3]) * u1[3]);
                *(u32x4*)rowp = o;
            }
    }
};
template <bool FIRST> struct EpiFfnB {
    static constexpr bool PERM = false;
    const float* x; const float* ctx; bf16_t* X1; float* out; const float* mods; int gate_i; int pm_off;
    __device__ __forceinline__ void operator()(const f32x4 (&acc)[2][2][4][2], const Unit& u, int wr, int wc, int fr, int fq) const {
        const int pmg = u.pm + pm_off;
        const int row0 = pmg * 256 + wr * 64 + fr, col0 = u.pn * 256 + wc * 32 + 4 * fq;
        const int b = pmg < 256 ? (pmg >> 5) : 8;
        f32x4 gv[2][2];
#pragma unroll
        for (int bj = 0; bj < 2; ++bj)
#pragma unroll
            for (int n = 0; n < 2; ++n) gv[bj][n] = 0.5f * *(const f32x4*)(mods + (size_t)b * NMOD + gate_i * 1024 + col0 + bj * 128 + n * 16);
#pragma unroll
        for (int ai = 0; ai < 2; ++ai)
#pragma unroll
            for (int m = 0; m < 4; ++m) {
                const int row = row0 + ai * 128 + m * 16;
                if (FIRST) {
                    const float* srow = (row < ML ? x + (size_t)row * D : ctx + (size_t)(row - ML) * D) + col0;
                    bf16_t* orow = X1 + (size_t)row * D + col0;
#pragma unroll
                    for (int bj = 0; bj < 2; ++bj)
#pragma unroll
                        for (int n = 0; n < 2; ++n) {
                            const f32x4 s = *(const f32x4*)(srow + bj * 128 + n * 16); const f32x4 r = s + gv[bj][n] * acc[ai][bj][m][n];
                            u32x2 o; o[0] = cvt_pk_bf16(r[0], r[1]); o[1] = cvt_pk_bf16(r[2], r[3]); *(u32x2*)(orow + bj * 128 + n * 16) = o;
                        }
                } else {
                    float* prow = out + (size_t)row * D + col0;
#pragma unroll
                    for (int bj = 0; bj < 2; ++bj)
#pragma unroll
                        for (int n = 0; n < 2; ++n) { f32x4* q = (f32x4*)(prow + bj * 128 + n * 16); *q = *q + gv[bj][n] * acc[ai][bj][m][n]; }
                }
            }
    }
};
template <int KIND>
__device__ __forceinline__ void store_act(const f32x4 (&acc)[2][2][4][2], bf16_t* dst, int ld, int cbase, int row0, int wc, int fq) {
#pragma unroll
    for (int ai = 0; ai < 2; ++ai)
#pragma unroll
        for (int m = 0; m < 4; ++m) {
            const int row = row0 + ai * 128 + m * 16;
#pragma unroll
            for (int bj = 0; bj < 2; ++bj) {
                const int col = cbase + bj * 128 + wc * 32 + 8 * fq;
                f32x4 v0 = acc[ai][bj][m][0], v1 = acc[ai][bj][m][1];
                if (KIND == 0) {
#pragma unroll
                    for (int j = 0; j < 4; ++j) { v0[j] = silu_f(v0[j]); v1[j] = silu_f(v1[j]); }
                } else if (KIND == 2) {
#pragma unroll
                    for (int j = 0; j < 4; ++j) { v0[j] = sigmoid_f(v0[j]); v1[j] = sigmoid_f(v1[j]); }
                }
                u32x4 o; o[0] = cvt_pk_bf16(v0[0], v0[1]); o[1] = cvt_pk_bf16(v0[2], v0[3]); o[2] = cvt_pk_bf16(v1[0], v1[1]); o[3] = cvt_pk_bf16(v1[2], v1[3]);
                *(u32x4*)(dst + (size_t)row * ld + col) = o;
            }
        }
}
struct EpiMix {
    static constexpr bool PERM = true;
    bf16_t *QKV, *SIDE, *GATE, *POOL, *MIXG; float* BG; const float* a_log; const float* dt_bias;
    __device__ __forceinline__ void operator()(const f32x4 (&acc)[2][2][4][2], const Unit& u, int wr, int wc, int fr, int fq) const {
        const int pn = u.pn, row0 = u.pm * 256 + wr * 64 + fr; const bool lat = u.pm < 256;
        if (pn < 12) {
#pragma unroll
            for (int ai = 0; ai < 2; ++ai)
#pragma unroll
                for (int m = 0; m < 4; ++m) {
                    const int row = row0 + ai * 128 + m * 16;
#pragma unroll
                    for (int bj = 0; bj < 2; ++bj) {
                        const int col = pn * 256 + bj * 128 + wc * 32 + 8 * fq;
                        const f32x4 v0 = acc[ai][bj][m][0], v1 = acc[ai][bj][m][1];
                        u32x4 o; o[0] = cvt_pk_bf16(v0[0], v0[1]); o[1] = cvt_pk_bf16(v0[2], v0[3]); o[2] = cvt_pk_bf16(v1[0], v1[1]); o[3] = cvt_pk_bf16(v1[2], v1[3]);
                        *(u32x4*)(QKV + (size_t)row * 3072 + col) = o;
                        if ((m == 0 && fr < 2) || (m == 3 && fr >= 14)) {
                            const int slot = (m == 0) ? fr : fr - 12; const int tile = row >> 6;
                            *(u32x4*)(SIDE + ((size_t)tile * 4 + slot) * 3072 + col) = o;
                        }
                    }
                }
        } else if (pn < 16) {
            if (!lat) return;
            store_act<0>(acc, GATE, 1024, (pn - 12) * 256, row0, wc, fq);
        } else if (pn < 18) {
            if (!lat) return;
            store_act<1>(acc, POOL, 512, (pn - 16) * 256, row0, wc, fq);
        } else if (pn < 26) {
            if (!lat) return;
            store_act<2>(acc, MIXG, 2048, (pn - 18) * 256, row0, wc, fq);
        } else {
            if (wc != 0) return;
            float al[8], db[8]; bool isg = fq >= 2;
#pragma unroll
            for (int j = 0; j < 8; ++j) { const int idx = (8 * fq + j) & 15; al[j] = __expf(a_log[idx]); db[j] = dt_bias[idx]; }
#pragma unroll
            for (int ai = 0; ai < 2; ++ai)
#pragma unroll
                for (int m = 0; m < 4; ++m) {
                    const int row = row0 + ai * 128 + m * 16;
                    f32x4 r[2];
#pragma unroll
                    for (int n = 0; n < 2; ++n)
#pragma unroll
                        for (int j = 0; j < 4; ++j) {
                            const float v = acc[ai][0][m][n][j];
                            r[n][j] = isg ? -al[4 * n + j] * softplus_f(v + db[4 * n + j]) : sigmoid_f(v);
                        }
                    float* bp = BG + (size_t)row * 32 + 8 * fq;
                    *(f32x4*)bp = r[0]; *(f32x4*)(bp + 4) = r[1];
                }
        }
    }
};
template <int MODE> struct EpiMerge {
    static constexpr bool PERM = true;
    const bf16_t* MIXG; const bf16_t* Tin; bf16_t* O;
    __device__ __forceinline__ void operator()(const f32x4 (&acc)[2][2][4][2], const Unit& u, int wr, int wc, int fr, int fq) const {
        const int row0 = u.pm * 256 + wr * 64 + fr;
#pragma unroll
        for (int ai = 0; ai < 2; ++ai)
#pragma unroll
            for (int m = 0; m < 4; ++m) {
                const int row = row0 + ai * 128 + m * 16;
#pragma unroll
                for (int bj = 0; bj < 2; ++bj) {
                    const int col = u.pn * 256 + bj * 128 + wc * 32 + 8 * fq;
                    const u32x4 gq = *(const u32x4*)(MIXG + (size_t)row * 2048 + (MODE ? 1024 : 0) + col);
                    const f32x4 v0 = acc[ai][bj][m][0], v1 = acc[ai][bj][m][1];
                    float r[8];
                    r[0] = bflo(gq[0]) * v0[0]; r[1] = bfhi(gq[0]) * v0[1]; r[2] = bflo(gq[1]) * v0[2]; r[3] = bfhi(gq[1]) * v0[3];
                    r[4] = bflo(gq[2]) * v1[0]; r[5] = bfhi(gq[2]) * v1[1]; r[6] = bflo(gq[3]) * v1[2]; r[7] = bfhi(gq[3]) * v1[3];
                    if (MODE) {
                        const u32x4 tq = *(const u32x4*)(Tin + (size_t)row * D + col);
                        r[0] += bflo(tq[0]); r[1] += bfhi(tq[0]); r[2] += bflo(tq[1]); r[3] += bfhi(tq[1]);
                        r[4] += bflo(tq[2]); r[5] += bfhi(tq[2]); r[6] += bflo(tq[3]); r[7] += bfhi(tq[3]);
                    }
                    u32x4 o; o[0] = cvt_pk_bf16(r[0], r[1]); o[1] = cvt_pk_bf16(r[2], r[3]); o[2] = cvt_pk_bf16(r[4], r[5]); o[3] = cvt_pk_bf16(r[6], r[7]);
                    *(u32x4*)(O + (size_t)row * D + col) = o;
                }
            }
    }
};
struct EpiMixOut {
    static constexpr bool PERM = false;
    const bf16_t* X1; float* out; const float* mods;
    __device__ __forceinline__ void operator()(const f32x4 (&acc)[2][2][4][2], const Unit& u, int wr, int wc, int fr, int fq) const {
        const int row0 = u.pm * 256 + wr * 64 + fr, col0 = u.pn * 256 + wc * 32 + 4 * fq;
        const int b = u.pm >> 5;
        f32x4 gv[2][2];
#pragma unroll
        for (int bj = 0; bj < 2; ++bj)
#pragma unroll
            for (int n = 0; n < 2; ++n) gv[bj][n] = *(const f32x4*)(mods + (size_t)b * NMOD + 5 * 1024 + col0 + bj * 128 + n * 16);
#pragma unroll
        for (int ai = 0; ai < 2; ++ai)
#pragma unroll
            for (int m = 0; m < 4; ++m) {
                const int row = row0 + ai * 128 + m * 16;
#pragma unroll
                for (int bj = 0; bj < 2; ++bj)
#pragma unroll
                    for (int n = 0; n < 2; ++n) {
                        const int col = col0 + bj * 128 + n * 16;
                        const u32x2 xq = *(const u32x2*)(X1 + (size_t)row * D + col);
                        f32x4 r; r[0] = bflo(xq[0]); r[1] = bfhi(xq[0]); r[2] = bflo(xq[1]); r[3] = bfhi(xq[1]);
                        r = r + gv[bj][n] * acc[ai][bj][m][n];
                        *(f32x4*)(out + (size_t)row * D + col) = r;
                    }
            }
    }
};

__device__ __forceinline__ void phase_mods(const Params& p, float* smem, float* mods) {
    const int tid = threadIdx.x;
    for (int i = tid; i < 9 * 1024; i += 512) { const int b = i >> 10, k = i & 1023; const float v = (b < 8) ? p.c[b * 1024 + k] : p.c_ctx[k]; smem[i] = silu_f(v); }
    __syncthreads();
    float* red = smem + 9 * 1024;
    for (int item = blockIdx.x; item < 144; item += gridDim.x) {
        const int cl = tid & 63, kg = tid >> 6, col = item * 64 + cl;
        float acc[9];
#pragma unroll
        for (int b = 0; b < 9; ++b) acc[b] = 0.f;
        for (int k = kg * 128; k < kg * 128 + 128; ++k) {
            const float w = p.w_ada[(size_t)k * NMOD + col];
#pragma unroll
            for (int b = 0; b < 9; ++b) acc[b] += smem[b * 1024 + k] * w;
        }
#pragma unroll
        for (int b = 0; b < 9; ++b) red[(kg * 9 + b) * 64 + cl] = acc[b];
        __syncthreads();
        for (int o = tid; o < 9 * 64; o += 512) {
            const int b = o >> 6, cc = o & 63; float s = p.b_ada[item * 64 + cc];
            for (int g = 0; g < 8; ++g) s += red[(g * 9 + b) * 64 + cc];
            mods[(size_t)b * NMOD + item * 64 + cc] = s;
        }
        __syncthreads();
    }
}
__device__ __forceinline__ int map_src(int map, int n) {
    if (map == 0) return n;
    if (map == 1) { const int pn = n >> 8, r = n & 255, hid = pn * 128 + (r & 127); return (r < 128) ? hid : DFF + hid; }
    if (n < 3072) return n;
    if (n < 4096) return 3104 + (n - 3072);
    if (n < 4608) return 4128 + (n - 4096);
    if (n < 6656) return 4640 + (n - 4608);
    if (n < 6688) return 3072 + (n - 6656);
    return -1;
}
__device__ __forceinline__ void tconv(const float* src, bf16_t* dst, int K, int N, int Np, int map, int& off, float* tile) {
    const int tk = K / 64, nt = tk * (Np / 64), G = gridDim.x, tid = threadIdx.x;
    const int start = (int)((blockIdx.x + G - (off % G)) % G); off += nt;
    float* tile2 = tile + 64 * 65;
    for (int t = start; t < nt; t += 2 * G) {
        const int t2 = t + G; const bool has2 = t2 < nt;
        const int n0 = (t / tk) * 64, k0 = (t % tk) * 64, n02 = has2 ? (t2 / tk) * 64 : n0, k02 = has2 ? (t2 % tk) * 64 : k0;
        { const int nl = tid & 63, sn = map_src(map, n0 + nl), sn2 = map_src(map, n02 + nl);
          float va[8], vb[8];
#pragma unroll
          for (int i = 0; i < 8; ++i) { const int kl = (tid >> 6) + 8 * i; va[i] = (sn >= 0) ? src[(size_t)(k0 + kl) * N + sn] : 0.f; vb[i] = (sn2 >= 0) ? src[(size_t)(k02 + kl) * N + sn2] : 0.f; }
#pragma unroll
          for (int i = 0; i < 8; ++i) { const int kl = (tid >> 6) + 8 * i; tile[kl * 65 + nl] = va[i]; tile2[kl * 65 + nl] = vb[i]; } }
        __syncthreads();
        { const int kl2 = (tid & 31) * 2;
#pragma unroll
          for (int i = 0; i < 4; ++i) { const int nl = (tid >> 5) + 16 * i;
              *(unsigned*)(dst + (size_t)(n0 + nl) * K + k0 + kl2) = cvt_pk_bf16(tile[kl2 * 65 + nl], tile[(kl2 + 1) * 65 + nl]);
              if (has2) *(unsigned*)(dst + (size_t)(n02 + nl) * K + k02 + kl2) = cvt_pk_bf16(tile2[kl2 * 65 + nl], tile2[(kl2 + 1) * 65 + nl]); } }
        __syncthreads();
    }
}

template <int SRC>
__device__ __forceinline__ void normmod_load(const float* x, const float* ctx, const bf16_t* sb, int row, int lane, float (&v)[16]) {
    if (SRC == 1) {
        const bf16_t* s = sb + (size_t)row * D + lane * 4;
#pragma unroll
        for (int i = 0; i < 4; ++i) { const u32x2 q = *(const u32x2*)(s + 256 * i); v[4 * i] = bflo(q[0]); v[4 * i + 1] = bfhi(q[0]); v[4 * i + 2] = bflo(q[1]); v[4 * i + 3] = bfhi(q[1]); }
    } else {
        const float* s = ((SRC == 0 && row >= ML) ? ctx + (size_t)(row - ML) * D : x + (size_t)row * D) + lane * 4;
#pragma unroll
        for (int i = 0; i < 4; ++i) { const f32x4 q = *(const f32x4*)(s + 256 * i); v[4 * i] = q[0]; v[4 * i + 1] = q[1]; v[4 * i + 2] = q[2]; v[4 * i + 3] = q[3]; }
    }
}
__device__ __forceinline__ void normmod_finish(int row, int lane, const float (&v)[16], bf16_t* dst, const float* nw, const float* mods, int shift_i, int scale_i) {
    const int b = row < ML ? (row >> 13) : 8;
    float ss = 0.f;
#pragma unroll
    for (int i = 0; i < 16; ++i) ss += v[i] * v[i];
    ss = wave_sum(ss);
    const float rstd = rsqrtf(ss * (1.f / 1024.f) + 1e-6f);
    const float* mb = mods + (size_t)b * NMOD;
#pragma unroll
    for (int i = 0; i < 4; ++i) {
        const int col = lane * 4 + 256 * i;
        const f32x4 w = *(const f32x4*)(nw + col), sc = *(const f32x4*)(mb + scale_i * 1024 + col), sh = *(const f32x4*)(mb + shift_i * 1024 + col);
        float y[4];
#pragma unroll
        for (int j = 0; j < 4; ++j) y[j] = v[4 * i + j] * rstd * w[j] * (1.f + sc[j]) + sh[j];
        u32x2 o; o[0] = cvt_pk_bf16(y[0], y[1]); o[1] = cvt_pk_bf16(y[2], y[3]);
        *(u32x2*)(dst + (size_t)row * D + col) = o;
    }
}
template <int SRC>
__device__ __forceinline__ void phase_normmod(const float* x, const float* ctx, const bf16_t* sb, bf16_t* dst, const float* nw, const float* mods, int shift_i, int scale_i, int nrows, int row_begin, int wg, int nwg) {
    const int wave = threadIdx.x >> 6, lane = threadIdx.x & 63, step = nwg * 8;
    for (int row = row_begin + wg * 8 + wave; row < nrows; row += 4 * step) {
        float v[4][16];
#pragma unroll
        for (int u = 0; u < 4; ++u) { const int ru = row + u * step; normmod_load<SRC>(x, ctx, sb, ru < nrows ? ru : row, lane, v[u]); }
#pragma unroll
        for (int u = 0; u < 4; ++u) { const int ru = row + u * step; if (ru < nrows) normmod_finish(ru, lane, v[u], dst, nw, mods, shift_i, scale_i); }
    }
}
__device__ __forceinline__ void phase_final_norm(float* out, const float* w) {
    const int wave = threadIdx.x >> 6, lane = threadIdx.x & 63, step = gridDim.x * 8;
    for (int row = blockIdx.x * 8 + wave; row < ML; row += 4 * step) {
        float* sp[4]; f32x4 q[4][4]; float ss[4];
#pragma unroll
        for (int u = 0; u < 4; ++u) { const int ru = row + u * step; sp[u] = out + (size_t)(ru < ML ? ru : row) * D + lane * 4; }
#pragma unroll
        for (int u = 0; u < 4; ++u)
#pragma unroll
            for (int i = 0; i < 4; ++i) q[u][i] = *(const f32x4*)(sp[u] + 256 * i);
#pragma unroll
        for (int u = 0; u < 4; ++u) { ss[u] = 0.f;
#pragma unroll
            for (int i = 0; i < 4; ++i) ss[u] += q[u][i][0] * q[u][i][0] + q[u][i][1] * q[u][i][1] + q[u][i][2] * q[u][i][2] + q[u][i][3] * q[u][i][3];
            ss[u] = wave_sum(ss[u]); }
#pragma unroll
        for (int i = 0; i < 4; ++i) { const f32x4 ww = *(const f32x4*)(w + lane * 4 + 256 * i);
#pragma unroll
            for (int u = 0; u < 4; ++u) { const float r = rsqrtf(ss[u] * (1.f / 1024.f) + 1e-6f); *(f32x4*)(sp[u] + 256 * i) = q[u][i] * r * ww; } }
    }
}

__device__ __forceinline__ void phase_conv(const Params& p, bf16_t* QKV, const bf16_t* SIDE, float* BG) {
    const int tid = threadIdx.x, rg = tid >> 6, cp = tid & 63;
    constexpr int NITEMS = (MT / 64) * 24;
    unsigned qn[12]; f32x2_t wn[5];
#define CONV_LOAD(ITEM) do { const int tile_ = (ITEM) / 24, cgp_ = (ITEM) % 24, t0_ = tile_ * 64, ch_ = cgp_ * 128 + cp * 2; \
        const bool first_ = tile_ < 1024 ? ((tile_ & 127) == 0) : (((tile_ - 1024) & 3) == 0); \
        const bool last_ = tile_ < 1024 ? ((tile_ & 127) == 127) : (((tile_ - 1024) & 3) == 3); \
        _Pragma("unroll") for (int i = 0; i < 12; ++i) { const int lr = rg * 8 - 2 + i; unsigned q = 0u; \
            if (lr >= 0 && lr < 64) q = *(const unsigned*)(QKV + (size_t)(t0_ + lr) * 3072 + ch_); \
            else if (lr < 0) { if (!first_) q = *(const unsigned*)(SIDE + ((size_t)(tile_ - 1) * 4 + (4 + lr)) * 3072 + ch_); } \
            else { if (!last_) q = *(const unsigned*)(SIDE + ((size_t)(tile_ + 1) * 4 + (lr - 64)) * 3072 + ch_); } \
            qn[i] = q; } \
        _Pragma("unroll") for (int k = 0; k < 5; ++k) wn[k] = *(const f32x2_t*)(p.conv_w + k * 3072 + ch_); } while (0)
    int item = blockIdx.x;
    if (item < NITEMS) CONV_LOAD(item);
    bool firstiter = true;
    for (; item < NITEMS; item += gridDim.x) {
        const int tile = item / 24, cgp = item % 24, t0 = tile * 64, ch = cgp * 128 + cp * 2;
        if (firstiter) asm volatile("s_waitcnt vmcnt(0)" ::: "memory"); else asm volatile("s_waitcnt vmcnt(8)" ::: "memory");
        firstiter = false;
        f32x2_t rr[12], wk[5];
#pragma unroll
        for (int i = 0; i < 12; ++i) { rr[i][0] = bflo(qn[i]); rr[i][1] = bfhi(qn[i]); }
#pragma unroll
        for (int k = 0; k < 5; ++k) wk[k] = wn[k];
        asm volatile("" ::: "memory");
        __syncthreads();
        if (item + (int)gridDim.x < NITEMS) CONV_LOAD(item + (int)gridDim.x);
        const float post = cgp < 8 ? 0.08838834764831845f : 1.f;
        f32x2_t y[8]; float ssq[8];
#pragma unroll
        for (int r = 0; r < 8; ++r) {
            f32x2_t acc = wk[0] * rr[r];
#pragma unroll
            for (int k = 1; k < 5; ++k) acc = acc + wk[k] * rr[r + k];
            const f32x2_t ne = acc * -1.4426950408889634f;
            f32x2_t d; d[0] = __builtin_amdgcn_exp2f(ne[0]); d[1] = __builtin_amdgcn_exp2f(ne[1]);
            d = d + 1.0f;
            f32x2_t rc; rc[0] = __builtin_amdgcn_rcpf(d[0]); rc[1] = __builtin_amdgcn_rcpf(d[1]);
            y[r] = acc * rc;
            const f32x2_t sq = y[r] * y[r];
            ssq[r] = sq[0] + sq[1];
        }
        if (cgp < 16) {
            const bool b0 = (cp & 1) != 0, b1 = (cp & 2) != 0, b2 = (cp & 4) != 0;
            float t4[4], t2[2], t1;
#pragma unroll
            for (int i = 0; i < 4; ++i) { const float keep = b0 ? ssq[i + 4] : ssq[i], send = b0 ? ssq[i] : ssq[i + 4]; t4[i] = keep + __shfl_xor(send, 1); }
#pragma unroll
            for (int i = 0; i < 2; ++i) { const float keep = b1 ? t4[i + 2] : t4[i], send = b1 ? t4[i] : t4[i + 2]; t2[i] = keep + __shfl_xor(send, 2); }
            { const float keep = b2 ? t2[1] : t2[0], send = b2 ? t2[0] : t2[1]; t1 = keep + __shfl_xor(send, 4); }
            t1 += __shfl_xor(t1, 8); t1 += __shfl_xor(t1, 16); t1 += __shfl_xor(t1, 32);
#pragma unroll
            for (int r = 0; r < 8; ++r) {
                const float tot = __int_as_float(__builtin_amdgcn_readlane(__float_as_int(t1), ((r >> 2) & 1) | (((r >> 1) & 1) << 1) | ((r & 1) << 2)));
                const float sc = rsqrtf(tot + 1e-6f) * post;
                y[r] = y[r] * sc;
            }
        }
#pragma unroll
        for (int r = 0; r < 8; ++r) *(unsigned*)(QKV + (size_t)(t0 + rg * 8 + r) * 3072 + ch) = cvt_pk_bf16(y[r][0], y[r][1]);
    }
#undef CONV_LOAD
    __syncthreads();
    { const int wave = tid >> 6, lane = tid & 63;
      for (int chunk = blockIdx.x * 8 + wave; chunk < MT / 64; chunk += gridDim.x * 8) {
          float* row = BG + ((size_t)chunk * 64 + lane) * 32 + 16;
          f32x4 g[4];
#pragma unroll
          for (int q = 0; q < 4; ++q) g[q] = *(const f32x4*)(row + 4 * q);
#pragma unroll
          for (int o = 1; o < 64; o <<= 1) {
#pragma unroll
              for (int q = 0; q < 4; ++q)
#pragma unroll
                  for (int e = 0; e < 4; ++e) {
                      const float up = __shfl_up(g[q][e], o), dn = __shfl_down(g[q][e], o);
                      if (q < 2) { if (lane >= o) g[q][e] += up; } else { if (lane + o < 64) g[q][e] += dn; }
                  }
          }
#pragma unroll
          for (int q = 0; q < 4; ++q) *(f32x4*)(row + 4 * q) = g[q];
      } }
}

template <int K>
__device__ __forceinline__ f32x4 mma_tile(const bf16_t* A, int lda, int row0, const bf16_t* Bt, int ldb, int col0, int lane) {
    f32x4 acc = {0.f, 0.f, 0.f, 0.f};
    const bf16_t* ap = A + (row0 + (lane & 15)) * lda + 8 * (lane >> 4);
    const bf16_t* bp = Bt + (col0 + (lane & 15)) * ldb + 8 * (lane >> 4);
#pragma unroll
    for (int k0 = 0; k0 < K; k0 += 32) acc = __builtin_amdgcn_mfma_f32_16x16x32_bf16(*(const bf16x8*)(ap + k0), *(const bf16x8*)(bp + k0), acc, 0, 0, 0);
    return acc;
}
constexpr int G_K = 0, G_KT = 17408, G_Q = 35840, G_V = 53248, G_ST = 61440, G_TB = 78848, G_AQK = 88064, G_NT = 97280, G_MROW = 106496, G_MT = 115712,
              G_PROW = 124928, G_RT = 134144, G_DINV = 143360, G_DINVT = 145408, G_M2T = 147456, G_DL = 147968, G_VEC = 152064, G_OS = 154112;
constexpr int G_VNT = G_MROW, G_VDT = G_MT;

__device__ __forceinline__ bf16x8 ld_frag_half(const bf16_t* p, int lq) {
    bf16x8 z = {0, 0, 0, 0, 0, 0, 0, 0};
    return lq < 2 ? *(const bf16x8*)p : z;
}

__device__ __forceinline__ void phase_gdn(unsigned char* sm, const bf16_t* QKV, const float* BG, bf16_t* OF, bf16_t* OB) {
    const int tid0 = threadIdx.x, wave = __builtin_amdgcn_readfirstlane(tid0 >> 6);
    bf16_t* Ks = (bf16_t*)(sm + G_K); bf16_t* KTs = (bf16_t*)(sm + G_KT); bf16_t* Qs = (bf16_t*)(sm + G_Q); bf16_t* Vs = (bf16_t*)(sm + G_V);
    bf16_t* STs = (bf16_t*)(sm + G_ST); bf16_t* TBs = (bf16_t*)(sm + G_TB); bf16_t* AQs = (bf16_t*)(sm + G_AQK);
    bf16_t* NTs = (bf16_t*)(sm + G_NT); bf16_t* MROW = (bf16_t*)(sm + G_MROW); bf16_t* MTs = (bf16_t*)(sm + G_MT); bf16_t* PROW = (bf16_t*)(sm + G_PROW);
    bf16_t* DINV = (bf16_t*)(sm + G_DINV); bf16_t* DINVT = (bf16_t*)(sm + G_DINVT); bf16_t* M2R = (bf16_t*)(sm + G_M2T);
    float* DL = (float*)(sm + G_DL); float* VEC = (float*)(sm + G_VEC); bf16_t* OSs = (bf16_t*)(sm + G_OS);
    bf16_t* RTs = (bf16_t*)(sm + G_RT); bf16_t* VNs = (bf16_t*)(sm + G_VNT); bf16_t* VDs = (bf16_t*)(sm + G_VDT);
    float* betas = VEC; float* cums = VEC + 64; float* ecums = VEC + 128; float* dds = VEC + 192;
    const int rb = wave >> 1, chh = wave & 1;
    for (int item = blockIdx.x; item < 256; item += gridDim.x) {
        const int half = item & 1, dir = (item >> 1) & 1, h = (item >> 2) & 7, b = item >> 5;
        f32x4 S[4];
#pragma unroll
        for (int n = 0; n < 4; ++n) S[n] = (f32x4){0.f, 0.f, 0.f, 0.f};
        for (int i = tid0; i < 64 * 136 / 2; i += 512) ((unsigned*)STs)[i] = 0u;
        for (int i = tid0; i < 64 * 72 / 2; i += 512) { ((unsigned*)TBs)[i] = 0u; ((unsigned*)AQs)[i] = 0u; }
        bf16_t* O = dir ? OB : OF;
        u32x4 pk0, pk1, pq0, pq1, pv; float pbeta = 0.f, pg = 0.f;
#define GDN_TOK(ci, i) ((ci) < 4 ? (ML + b * 256 + (dir ? 255 - 64 * (ci) - (i) : 64 * (ci) + (i))) : (b * 8192 + (dir ? 8191 - 64 * ((ci) - 4) - (i) : 64 * ((ci) - 4) + (i))))
#define GDN_ISSUE(ci) do { \
            { const size_t ta = (size_t)GDN_TOK(ci, lane) * 3072 + 128 * h + 16 * wave; \
              pk0 = *(const u32x4*)(QKV + ta + 1024); pk1 = *(const u32x4*)(QKV + ta + 1024 + 8); \
              pq0 = *(const u32x4*)(QKV + ta); pq1 = *(const u32x4*)(QKV + ta + 8); \
              pv = *(const u32x4*)(QKV + (size_t)GDN_TOK(ci, lane) * 3072 + 2048 + 128 * h + 64 * half + 8 * wave); } \
            if (wave == 0) { const size_t tk = (size_t)GDN_TOK(ci, lane) * 32; pbeta = BG[tk + dir * 8 + h]; pg = BG[tk + 16 + dir * 8 + h]; } } while (0)
        { const int tid = tid0, lane = tid & 63; GDN_ISSUE(0); }
        for (int ci = 0; ci < 132; ++ci) {
            int tid_o = tid0; asm volatile("" : "+v"(tid_o));
            const int tid = tid_o, lane = tid & 63, l15 = lane & 15, lq = lane >> 4;
            { *(u32x4*)(Ks + lane * 136 + 16 * wave) = pk0; *(u32x4*)(Ks + lane * 136 + 16 * wave + 8) = pk1;
              *(u32x4*)(Qs + lane * 136 + 16 * wave) = pq0; *(u32x4*)(Qs + lane * 136 + 16 * wave + 8) = pq1;
#pragma unroll
              for (int e = 0; e < 4; ++e) {
                  KTs[(16 * wave + 2 * e) * 72 + lane] = (bf16_t)(pk0[e] & 0xffffu); KTs[(16 * wave + 2 * e + 1) * 72 + lane] = (bf16_t)(pk0[e] >> 16);
                  KTs[(16 * wave + 8 + 2 * e) * 72 + lane] = (bf16_t)(pk1[e] & 0xffffu); KTs[(16 * wave + 8 + 2 * e + 1) * 72 + lane] = (bf16_t)(pk1[e] >> 16);
              }
              *(u32x4*)(Vs + lane * 64 + 8 * wave) = pv; }
            if (wave == 0) {
                const float c = pg;
                const float cl = __shfl(c, 63);
                betas[lane] = pbeta; cums[lane] = c; ecums[lane] = __expf(c); dds[lane] = __expf(cl - c);
                if (lane == 63) VEC[256] = __expf(c);
            }
            __syncthreads();
            if (ci >= 5) { const int orow = tid >> 3, opc = tid & 7; *(u32x4*)(O + (size_t)GDN_TOK(ci - 1, orow) * 1024 + 128 * h + 64 * half + 8 * opc) = *(const u32x4*)(OSs + orow * 72 + 8 * opc); }
            if (ci + 1 < 132) GDN_ISSUE(ci + 1);
#pragma unroll
            for (int n = 0; n < 2; ++n) {
                const int col0 = 32 * chh + 16 * n;
                const f32x4 KS = mma_tile<128>(Ks, 136, 16 * rb, STs, 136, col0, lane);
                const int c = col0 + l15, i0 = 16 * rb + 4 * lq;
                float r[4];
                const f32x4 b4 = *(const f32x4*)(betas + i0), e4 = *(const f32x4*)(ecums + i0);
#pragma unroll
                for (int q = 0; q < 4; ++q) { const int i = i0 + q; r[q] = b4[q] * (bf2f(Vs[i * 64 + c]) - e4[q] * KS[q]); }
                u32x2 o; o[0] = cvt_pk_bf16(r[0], r[1]); o[1] = cvt_pk_bf16(r[2], r[3]);
                *(u32x2*)(RTs + c * 72 + i0) = o;
            }
            {
                const int tabv = (wave < 4) ? (wave | wave << 2)
                               : (wave == 4) ? (1 | 0 << 2 | 1 << 4 | 2 << 5 | 0 << 7) : (wave == 5) ? (2 | 1 << 2) : (wave == 6) ? (3 | 0 << 2 | 1 << 4 | 3 << 5 | 1 << 7) : (3 | 2 << 2);
                const int ntile = 1 + ((tabv >> 4) & 1);
                for (int tix = 0; tix < ntile; ++tix) {
                    const int trb = tix ? ((tabv >> 5) & 3) : (tabv & 3), tcb = tix ? ((tabv >> 7) & 3) : ((tabv >> 2) & 3), col0 = 16 * tcb;
                    const f32x4 P = mma_tile<128>(Ks, 136, 16 * trb, Ks, 136, col0, lane);
                    const f32x4 P2 = mma_tile<128>(Qs, 136, 16 * trb, Ks, 136, col0, lane);
                    const int j = col0 + l15; const float cj = cums[j];
                    const f32x4 ci4 = *(const f32x4*)(cums + 16 * trb + 4 * lq), bi4 = *(const f32x4*)(betas + 16 * trb + 4 * lq);
                    float lv[4];
                    if (tcb == trb) {
#pragma unroll
                        for (int r = 0; r < 4; ++r) {
                            const int i = 16 * trb + 4 * lq + r;
                            const float dec = (i >= j) ? __expf(ci4[r] - cj) : 0.f;
                            lv[r] = (i > j) ? bi4[r] * P[r] * dec : 0.f;
                            AQs[i * 72 + j] = f2bf(P2[r] * dec);
                        }
                    } else {
#pragma unroll
                        for (int r = 0; r < 4; ++r) {
                            const int i = 16 * trb + 4 * lq + r;
                            const float dec = __expf(ci4[r] - cj);
                            lv[r] = bi4[r] * P[r] * dec;
                            AQs[i * 72 + j] = f2bf(P2[r] * dec);
                        }
                    }
                    if (tcb == trb) {
                        *(f32x4*)(DL + trb * 256 + l15 * 16 + 4 * lq) = (f32x4){lv[0], lv[1], lv[2], lv[3]};
                        __builtin_amdgcn_fence(__ATOMIC_RELEASE, "wavefront"); __builtin_amdgcn_wave_barrier(); __builtin_amdgcn_fence(__ATOMIC_ACQUIRE, "wavefront");
                        if (lane < 16) {
                            const int blk = trb, c = lane;
                            const float* dl = DL + blk * 256;
                            f32x2_t sp[8];
#pragma unroll
                            for (int k = 0; k < 8; ++k) { sp[k][0] = (2 * k == c) ? 1.f : 0.f; sp[k][1] = (2 * k + 1 == c) ? 1.f : 0.f; }
#pragma unroll
                            for (int j = 0; j < 15; ++j) {
                                const float xj = sp[j >> 1][j & 1];
                                const f32x2_t xj2 = {xj, xj};
                                if ((j & 1) == 0) sp[j >> 1][1] -= dl[j * 16 + j + 1] * xj;
#pragma unroll
                                for (int k = (j >> 1) + 1; k < 8; ++k) { const f32x2_t l2 = *(const f32x2_t*)(dl + j * 16 + 2 * k); sp[k] = sp[k] - l2 * xj2; }
                            }
#pragma unroll
                            for (int i = 0; i < 16; ++i) DINV[blk * 256 + i * 16 + c] = f2bf(sp[i >> 1][i & 1]);
                            u32x4 t0, t1;
#pragma unroll
                            for (int e = 0; e < 4; ++e) { t0[e] = cvt_pk_bf16(sp[e][0], sp[e][1]); t1[e] = cvt_pk_bf16(sp[4 + e][0], sp[4 + e][1]); }
                            *(u32x4*)(DINVT + blk * 256 + c * 16) = t0; *(u32x4*)(DINVT + blk * 256 + c * 16 + 8) = t1;
                        }
                    } else {
                        u32x2 o; o[0] = cvt_pk_bf16(lv[0], lv[1]); o[1] = cvt_pk_bf16(lv[2], lv[3]);
                        *(u32x2*)(NTs + (col0 + l15) * 72 + 16 * trb + 4 * lq) = o;
                    }
                }
            }
            __syncthreads();
            f32x4 mreg[2], m2reg[2];
#pragma unroll
            for (int n = 0; n < 2; ++n) {
                const int cb = 2 * chh + n;
                mreg[n] = (f32x4){0.f, 0.f, 0.f, 0.f}; m2reg[n] = (f32x4){0.f, 0.f, 0.f, 0.f};
                if (cb < rb) {
                    const bf16x8 a = ld_frag_half(DINV + rb * 256 + l15 * 16 + 8 * lq, lq);
                    const bf16x8 bq = ld_frag_half(NTs + (16 * cb + l15) * 72 + 16 * rb + 8 * lq, lq);
                    mreg[n] = __builtin_amdgcn_mfma_f32_16x16x32_bf16(a, bq, mreg[n], 0, 0, 0);
#pragma unroll
                    for (int r = 0; r < 4; ++r) MROW[(16 * rb + 4 * lq + r) * 72 + 16 * cb + l15] = f2bf(mreg[n][r]);
                    u32x2 o; o[0] = cvt_pk_bf16(mreg[n][0], mreg[n][1]); o[1] = cvt_pk_bf16(mreg[n][2], mreg[n][3]);
                    *(u32x2*)(MTs + (16 * cb + l15) * 72 + 16 * rb + 4 * lq) = o;
                }
            }
            __syncthreads();
#pragma unroll
            for (int nn = 0; nn < 2; ++nn) {
                const int n = 1 - nn, cb = 2 * chh + n;
                if (cb <= rb) {
                    f32x4 m3 = {0.f, 0.f, 0.f, 0.f};
                    if (rb - cb >= 2) {
                        const int k0 = 16 * (cb + 1); const bool wide = (rb - cb == 3);
                        const bf16x8 z = {0, 0, 0, 0, 0, 0, 0, 0};
                        const bf16x8 a = (wide || lq < 2) ? *(const bf16x8*)(MROW + (16 * rb + l15) * 72 + k0 + 8 * lq) : z;
                        const bf16x8 bq = (wide || lq < 2) ? *(const bf16x8*)(MTs + (16 * cb + l15) * 72 + k0 + 8 * lq) : z;
                        m2reg[n] = __builtin_amdgcn_mfma_f32_16x16x32_bf16(a, bq, m2reg[n], 0, 0, 0);
                        if (rb == 3 && cb == 1) {
#pragma unroll
                            for (int r = 0; r < 4; ++r) M2R[(4 * lq + r) * 16 + l15] = f2bf(m2reg[n][r]);
                            __builtin_amdgcn_fence(__ATOMIC_RELEASE, "wavefront"); __builtin_amdgcn_wave_barrier(); __builtin_amdgcn_fence(__ATOMIC_ACQUIRE, "wavefront");
                        }
                        if (rb == 3 && cb == 0) {
                            const bf16x8 a3 = ld_frag_half(M2R + l15 * 16 + 8 * lq, lq);
                            const bf16x8 b3 = ld_frag_half(MTs + l15 * 72 + 16 + 8 * lq, lq);
                            m3 = __builtin_amdgcn_mfma_f32_16x16x32_bf16(a3, b3, m3, 0, 0, 0);
                        }
                    }
#pragma unroll
                    for (int r = 0; r < 4; ++r) {
                        const float idv = (cb == rb && (4 * lq + r) == l15) ? 1.f : 0.f;
                        PROW[(16 * rb + 4 * lq + r) * 72 + 16 * cb + l15] = f2bf(idv + m2reg[n][r] - mreg[n][r] - m3[r]);
                    }
                    __builtin_amdgcn_fence(__ATOMIC_RELEASE, "wavefront"); __builtin_amdgcn_wave_barrier(); __builtin_amdgcn_fence(__ATOMIC_ACQUIRE, "wavefront");
                    const bf16x8 a = ld_frag_half(PROW + (16 * rb + l15) * 72 + 16 * cb + 8 * lq, lq);
                    const bf16x8 bq = ld_frag_half(DINVT + cb * 256 + l15 * 16 + 8 * lq, lq);
                    f32x4 t = {0.f, 0.f, 0.f, 0.f};
                    t = __builtin_amdgcn_mfma_f32_16x16x32_bf16(a, bq, t, 0, 0, 0);
#pragma unroll
                    for (int r = 0; r < 4; ++r) TBs[(16 * rb + 4 * lq + r) * 72 + 16 * cb + l15] = f2bf(t[r]);
                }
            }
            __syncthreads();
#pragma unroll
            for (int n = 0; n < 2; ++n) {
                const int col0 = 32 * chh + 16 * n;
                const f32x4 VN = mma_tile<64>(TBs, 72, 16 * rb, RTs, 72, col0, lane);
                const int c = col0 + l15, i0 = 16 * rb + 4 * lq;
                u32x2 o; o[0] = cvt_pk_bf16(VN[0], VN[1]); o[1] = cvt_pk_bf16(VN[2], VN[3]);
                *(u32x2*)(VNs + c * 72 + i0) = o;
                const f32x4 d4 = *(const f32x4*)(dds + i0);
                u32x2 o2; o2[0] = cvt_pk_bf16(VN[0] * d4[0], VN[1] * d4[1]); o2[1] = cvt_pk_bf16(VN[2] * d4[2], VN[3] * d4[3]);
                *(u32x2*)(VDs + c * 72 + i0) = o2;
            }
            __syncthreads();
            if (ci >= 4) {
#pragma unroll
                for (int n = 0; n < 2; ++n) {
                    const int col0 = 32 * chh + 16 * n;
                    const f32x4 A1 = mma_tile<128>(Qs, 136, 16 * rb, STs, 136, col0, lane);
                    const f32x4 A2 = mma_tile<64>(AQs, 72, 16 * rb, VNs, 72, col0, lane);
                    const int c = col0 + l15, i0 = 16 * rb + 4 * lq;
                    const f32x4 e4 = *(const f32x4*)(ecums + i0);
#pragma unroll
                    for (int q = 0; q < 4; ++q) { const int i = i0 + q; OSs[i * 72 + c] = f2bf(e4[q] * A1[q] + A2[q]); }
                }
            }
            { const float bl = VEC[256];
#pragma unroll
              for (int n = 0; n < 4; ++n) { const f32x4 A3 = mma_tile<64>(KTs, 72, 16 * wave, VDs, 72, 16 * n, lane); S[n] = S[n] * bl + A3; } }
            __syncthreads();
#pragma unroll
            for (int n = 0; n < 4; ++n) {
                const int c = 16 * n + l15, r0 = 16 * wave + 4 * lq;
                u32x2 o; o[0] = cvt_pk_bf16(S[n][0], S[n][1]); o[1] = cvt_pk_bf16(S[n][2], S[n][3]);
                *(u32x2*)(STs + c * 136 + r0) = o;
            }
        }
        __syncthreads();
        { const int tid = tid0, orow = tid >> 3, opc = tid & 7; *(u32x4*)(O + (size_t)GDN_TOK(131, orow) * 1024 + 128 * h + 64 * half + 8 * opc) = *(const u32x4*)(OSs + orow * 72 + 8 * opc); }
        __syncthreads();
#undef GDN_TOK
#undef GDN_ISSUE
    }
}

__device__ __forceinline__ void phase_pool(const Params& p, unsigned char* sm, const bf16_t* POOL, const bf16_t* WTPOOLW, bf16_t* PP) {
    const int tid = threadIdx.x, wave = tid >> 6, lane = tid & 63;
    float* Vsum = (float*)sm;
    bf16_t* As = (bf16_t*)(sm + 33792);
    const int c = tid >> 3, ch0 = (tid & 7) * 16;
    for (int item = blockIdx.x; item < 8 * 4 * 128; item += gridDim.x) {
        const int r = item & 127, g = (item >> 7) & 3, b = item >> 9;
        const int hw = 1 << g;
        const int rlo = max(r - hw, 0), rhi = min(r + hw, 128);
        float vs[16], xr[16];
#pragma unroll
        for (int e = 0; e < 16; ++e) vs[e] = 0.f;
        { const bf16_t* src = POOL + ((size_t)(b * 8192 + r * 64 + c)) * 512 + g * 128 + ch0;
          const u32x4 a = *(const u32x4*)src, bq = *(const u32x4*)(src + 8);
#pragma unroll
          for (int e = 0; e < 4; ++e) { xr[2 * e] = bflo(a[e]); xr[2 * e + 1] = bfhi(a[e]); xr[8 + 2 * e] = bflo(bq[e]); xr[8 + 2 * e + 1] = bfhi(bq[e]); } }
        for (int rr0 = rlo; rr0 < rhi; rr0 += 4) {
            u32x4 av[4], bv[4];
#pragma unroll
            for (int u = 0; u < 4; ++u) {
                const int rr = min(rr0 + u, rhi - 1);
                const bf16_t* src = POOL + ((size_t)(b * 8192 + rr * 64 + c)) * 512 + g * 128 + ch0;
                av[u] = *(const u32x4*)src; bv[u] = *(const u32x4*)(src + 8);
            }
#pragma unroll
            for (int u = 0; u < 4; ++u) {
                if (rr0 + u < rhi) {
#pragma unroll
                    for (int e = 0; e < 4; ++e) { vs[2 * e] += bflo(av[u][e]); vs[2 * e + 1] += bfhi(av[u][e]); vs[8 + 2 * e] += bflo(bv[u][e]); vs[8 + 2 * e + 1] += bfhi(bv[u][e]); }
                }
            }
        }
#pragma unroll
        for (int e = 0; e < 4; ++e) *(f32x4*)(Vsum + c * 132 + ch0 + 4 * e) = (f32x4){vs[4 * e], vs[4 * e + 1], vs[4 * e + 2], vs[4 * e + 3]};
        __syncthreads();
        const int clo = max(c - hw, 0), chi = min(c + hw, 64);
        float hs[16];
#pragma unroll
        for (int e = 0; e < 16; ++e) hs[e] = 0.f;
        for (int cc = clo; cc < chi; ++cc) {
#pragma unroll
            for (int e = 0; e < 4; ++e) { const f32x4 q = *(const f32x4*)(Vsum + cc * 132 + ch0 + 4 * e); hs[4 * e] += q[0]; hs[4 * e + 1] += q[1]; hs[4 * e + 2] += q[2]; hs[4 * e + 3] += q[3]; }
        }
        const float inv = 1.f / (float)((rhi - rlo) * (chi - clo));
        u32x4 o0, o1;
#pragma unroll
        for (int e = 0; e < 4; ++e) { o0[e] = cvt_pk_bf16(hs[2 * e] * inv - xr[2 * e], hs[2 * e + 1] * inv - xr[2 * e + 1]); o1[e] = cvt_pk_bf16(hs[8 + 2 * e] * inv - xr[8 + 2 * e], hs[8 + 2 * e + 1] * inv - xr[8 + 2 * e + 1]); }
        *(u32x4*)(As + c * 136 + ch0) = o0; *(u32x4*)(As + c * 136 + ch0 + 8) = o1;
        __syncthreads();
        const bf16_t* Bt = WTPOOLW + g * 16384 + (16 * wave + (lane & 15)) * 128 + 8 * (lane >> 4);
        bf16x8 bf[4];
#pragma unroll
        for (int ks = 0; ks < 4; ++ks) bf[ks] = *(const bf16x8*)(Bt + 32 * ks);
        const int e = 16 * wave + (lane & 15); const float sc = p.pool_scale[g * 128 + e];
#pragma unroll
        for (int rbk = 0; rbk < 4; ++rbk) {
            f32x4 acc = {0.f, 0.f, 0.f, 0.f};
#pragma unroll
            for (int ks = 0; ks < 4; ++ks) acc = __builtin_amdgcn_mfma_f32_16x16x32_bf16(*(const bf16x8*)(As + (16 * rbk + (lane & 15)) * 136 + 32 * ks + 8 * (lane >> 4)), bf[ks], acc, 0, 0, 0);
#pragma unroll
            for (int q = 0; q < 4; ++q) { const int tok = 16 * rbk + 4 * (lane >> 4) + q; PP[((size_t)(b * 8192 + r * 64 + tok)) * 512 + g * 128 + e] = f2bf(acc[q] * sc); }
        }
        __syncthreads();
    }
}

__device__ __forceinline__ void onorm_item(const Params& p, bf16_t* OF, size_t idx, const u32x4 a, const u32x4 bq, const u32x4 gq) {
    const size_t off = idx * 8; const int c8 = (int)(idx & 127) * 8;
    float o[8], ss = 0.f;
#pragma unroll
    for (int e = 0; e < 4; ++e) { o[2 * e] = bflo(a[e]) + bflo(bq[e]); o[2 * e + 1] = bfhi(a[e]) + bfhi(bq[e]); }
#pragma unroll
    for (int e = 0; e < 8; ++e) ss += o[e] * o[e];
    ss += __shfl_xor(ss, 1); ss += __shfl_xor(ss, 2); ss += __shfl_xor(ss, 4); ss += __shfl_xor(ss, 8);
    const float rstd = rsqrtf(ss * (1.f / 128.f) + 1e-6f);
    const f32x4 w0 = *(const f32x4*)(p.gdn_norm_w + (c8 & 127)), w1 = *(const f32x4*)(p.gdn_norm_w + (c8 & 127) + 4);
    u32x4 r;
    r[0] = cvt_pk_bf16(o[0] * rstd * w0[0] * bflo(gq[0]), o[1] * rstd * w0[1] * bfhi(gq[0]));
    r[1] = cvt_pk_bf16(o[2] * rstd * w0[2] * bflo(gq[1]), o[3] * rstd * w0[3] * bfhi(gq[1]));
    r[2] = cvt_pk_bf16(o[4] * rstd * w1[0] * bflo(gq[2]), o[5] * rstd * w1[1] * bfhi(gq[2]));
    r[3] = cvt_pk_bf16(o[6] * rstd * w1[2] * bflo(gq[3]), o[7] * rstd * w1[3] * bfhi(gq[3]));
    *(u32x4*)(OF + off) = r;
}
__device__ __forceinline__ void phase_onorm(const Params& p, bf16_t* OF, const bf16_t* OB, const bf16_t* GATE) {
    const size_t nthr = (size_t)gridDim.x * 512, total = (size_t)ML * 128;
    for (size_t idx = (size_t)blockIdx.x * 512 + threadIdx.x; idx < total; idx += 2 * nthr) {
        const size_t idx2 = (idx + nthr < total) ? idx + nthr : idx;
        const u32x4 a0 = *(const u32x4*)(OF + idx * 8), b0 = *(const u32x4*)(OB + idx * 8), g0 = *(const u32x4*)(GATE + idx * 8);
        const u32x4 a1 = *(const u32x4*)(OF + idx2 * 8), b1 = *(const u32x4*)(OB + idx2 * 8), g1 = *(const u32x4*)(GATE + idx2 * 8);
        onorm_item(p, OF, idx, a0, b0, g0);
        if (idx2 != idx) onorm_item(p, OF, idx2, a1, b1, g1);
    }
}

#define XB_TMO      128
#define XB_XCNT(j)  (256  + 64 * (j))
#define XB_XSUB(j)  (1280 + 64 * (j))
#define XB_XGEN(j)  (2304 + 64 * (j))
#define XB_TOP      3328
#define XB_TOPGEN   3392
#define XCD_BAR_WORDS 3456
#define XB_SPIN_CAP (1u << 18)
__device__ __forceinline__ unsigned xb_ld(unsigned* p)              { return __hip_atomic_load(p, __ATOMIC_RELAXED, __HIP_MEMORY_SCOPE_AGENT); }
__device__ __forceinline__ unsigned xb_add(unsigned* p, unsigned v) { return __hip_atomic_fetch_add(p, v, __ATOMIC_RELAXED, __HIP_MEMORY_SCOPE_AGENT); }
__device__ __forceinline__ unsigned xb_xcc_id() { return (unsigned)__builtin_amdgcn_s_getreg((3 << 11) | 20) & 0xFu; }
#define XB_SPIN(cond, bar) do { unsigned _sp = 0; while (cond) { __builtin_amdgcn_s_sleep(1); \
    if ((++_sp & 255u) == 0u) { if (xb_ld(&(bar)[XB_TMO])) break; if (_sp > XB_SPIN_CAP) { atomicAdd(&(bar)[XB_TMO], 1u); break; } } } } while (0)
struct XcdBarrier { unsigned* bar; unsigned x; volatile LAS unsigned* st; };
__device__ __forceinline__ XcdBarrier xcd_barrier_post(unsigned* bar, volatile LAS unsigned* st) {
    XcdBarrier b; b.bar = bar; b.x = xb_xcc_id(); b.st = st;
    if (threadIdx.x == 0) st[2] = xb_add(&bar[XB_XCNT(b.x)], 1u);
    return b;
}
__device__ __forceinline__ void xcd_barrier_complete(unsigned* bar, unsigned x, unsigned& nloc, unsigned& nx) {
    const unsigned G = gridDim.x * gridDim.y * gridDim.z;
    unsigned sum, cnt, mine, sp = 0u;
    for (;;) {
        sum = 0u; cnt = 0u; mine = 0u;
#pragma unroll
        for (unsigned j = 0; j < 16; ++j) { const unsigned c = xb_ld(&bar[XB_XCNT(j)]); sum += c; cnt += (c > 0u) ? 1u : 0u; mine = (j == x) ? c : mine; }
        if (sum == G) break;
        __builtin_amdgcn_s_sleep(1);
        if ((++sp & 255u) == 0u) { if (xb_ld(&bar[XB_TMO])) break; if (sp > XB_SPIN_CAP) { atomicAdd(&bar[XB_TMO], 1u); break; } }
    }
    nloc = mine > 0u ? mine : 1u; nx = cnt > 0u ? cnt : 1u;
}
__device__ __forceinline__ void xcd_barrier(const XcdBarrier& b) {
    asm volatile("s_waitcnt vmcnt(0)" ::: "memory");
    __syncthreads();
    if (threadIdx.x == 0) {
        unsigned* bar = b.bar;
        __builtin_amdgcn_s_waitcnt(0);
        unsigned nloc = b.st[0], nx = b.st[1];
        if (nloc == 0u) { xcd_barrier_complete(bar, b.x, nloc, nx); b.st[0] = nloc; b.st[1] = nx; }
        const unsigned old = xb_add(&bar[XB_XSUB(b.x)], 1u);
        const unsigned gen = old / nloc;
        if (old + 1u == (gen + 1u) * nloc) {
            __builtin_amdgcn_fence(__ATOMIC_RELEASE, "agent");
            asm volatile("s_waitcnt vmcnt(0)" ::: "memory");
            const unsigned og = xb_add(&bar[XB_TOP], 1u);
            const unsigned tg = og / nx;
            if (og + 1u == (tg + 1u) * nx) xb_add(&bar[XB_TOPGEN], 1u);
            else XB_SPIN(xb_ld(&bar[XB_TOPGEN]) == tg, bar);
            __builtin_amdgcn_fence(__ATOMIC_ACQUIRE, "agent");
            xb_add(&bar[XB_XGEN(b.x)], 1u);
            asm volatile("s_waitcnt vmcnt(0)" ::: "memory");
        } else {
            XB_SPIN(xb_ld(&bar[XB_XGEN(b.x)]) == gen, bar);
            __builtin_amdgcn_fence(__ATOMIC_ACQUIRE, "agent");
            asm volatile("s_waitcnt vmcnt(0)" ::: "memory");
        }
    }
    __syncthreads();
}

#define GSYNC() xcd_barrier(xb)
#define GSYNC_CG() do { asm volatile("s_waitcnt vmcnt(0) lgkmcnt(0)" ::: "memory"); grid.sync(); } while (0)
__global__ void __launch_bounds__(512, 2) fwd_megakernel(Params p) {
    extern __shared__ __attribute__((aligned(16))) unsigned char shm[];
    cg::grid_group grid = cg::this_grid();
    LAS unsigned char* lds = (LAS unsigned char*)shm;
    const int G = gridDim.x, bid = blockIdx.x;
    pg8::StaticOrder S;
    volatile LAS unsigned* xb_st = (volatile LAS unsigned*)(lds + (kDynLds - 16));
    if (threadIdx.x == 0) { xb_st[0] = 0u; xb_st[1] = 0u; }
    __syncthreads();
    const XcdBarrier xb = xcd_barrier_post((unsigned*)(p.ws + WS_BAR), xb_st);

    phase_mods(p, (float*)shm, ((float*)((unsigned char*)p.ws + WS_MODS)));
    { int off = 0; float* tile = (float*)shm;
      tconv(p.ffn1_w_in, ((bf16_t*)((unsigned char*)p.out + DO_WTFFN1IN)), 1024, 2 * DFF, 2 * DFF, 1, off, tile);
      tconv(p.ffn1_w_out, ((bf16_t*)((unsigned char*)p.out + DO_WTFFN1OUT)), DFF, 1024, 1024, 0, off, tile);
      tconv(p.w_mix_in, ((bf16_t*)((unsigned char*)p.out + DO_WTMIX)), 1024, 6688, NMIX, 2, off, tile);
      tconv(p.w_gdn_proj, ((bf16_t*)((unsigned char*)p.ws + WS_WTGDN)), 1024, 1024, 1024, 0, off, tile);
      tconv(p.w_pool_proj, ((bf16_t*)((unsigned char*)p.ws + WS_WTPOOL)), 512, 1024, 1024, 0, off, tile);
      tconv(p.w_mix_out, ((bf16_t*)((unsigned char*)p.ws + WS_WTMIXOUT)), 1024, 1024, 1024, 0, off, tile);
      tconv(p.ffn2_w_in, ((bf16_t*)((unsigned char*)p.ws + WS_WTFFN2IN)), 1024, 2 * DFF, 2 * DFF, 1, off, tile);
      tconv(p.ffn2_w_out, ((bf16_t*)((unsigned char*)p.ws + WS_WTFFN2OUT)), DFF, 1024, 1024, 0, off, tile);
      for (int g = 0; g < 4; ++g) tconv(p.pool_w + g * 16384, ((bf16_t*)((unsigned char*)p.ws + WS_WTPOOLW)) + g * 16384, 128, 128, 128, 0, off, tile); }
    GSYNC_CG();
    if (threadIdx.x == 0) {
        unsigned ok = ((unsigned)G % 8u == 0u && xb.x < 8u) ? 1u : 0u;
        for (unsigned j8 = 0; j8 < 8u; ++j8) ok &= (xb_ld(&xb.bar[XB_XCNT(j8)]) == (unsigned)G / 8u) ? 1u : 0u;
        xb_st[3] = ok ? (xb_st[2] * 8u + xb.x) : (unsigned)bid;
    }
    __syncthreads();
    const int cvirt = __builtin_amdgcn_readfirstlane((int)xb_st[3]);
    phase_normmod<0>(p.x, p.ctx, nullptr, ((bf16_t*)((unsigned char*)p.out + DO_H)), p.norm1_w, ((float*)((unsigned char*)p.ws + WS_MODS)), 0, 1, MT, 0, bid, G);
    GSYNC();
    { S.init(MT, 2 * DFF, G, cvirt); pg8::gemm_phase(lds, pg8::Gemm{((bf16_t*)((unsigned char*)p.out + DO_H)), ((bf16_t*)((unsigned char*)p.out + DO_WTFFN1IN)), MT, 2 * DFF, 1024}, S, EpiFfnA{((bf16_t*)((unsigned char*)p.ws + WS_HID))}); }
    GSYNC();
    { S.init(ML, 1024, G, cvirt); pg8::gemm_phase(lds, pg8::Gemm{((bf16_t*)((unsigned char*)p.ws + WS_HID)), ((bf16_t*)((unsigned char*)p.out + DO_WTFFN1OUT)), ML, 1024, DFF}, S, EpiFfnB<true>{p.x, p.ctx, ((bf16_t*)((unsigned char*)p.ws + WS_X1)), nullptr, ((float*)((unsigned char*)p.ws + WS_MODS)), 2, 0}); }
    GSYNC();
    if (cvirt < 32) { S.init(MC, 1024, 32, cvirt); pg8::gemm_phase(lds, pg8::Gemm{((bf16_t*)((unsigned char*)p.ws + WS_HID)) + (size_t)ML * DFF, ((bf16_t*)((unsigned char*)p.out + DO_WTFFN1OUT)), MC, 1024, DFF}, S, EpiFfnB<true>{p.x, p.ctx, ((bf16_t*)((unsigned char*)p.ws + WS_X1)), nullptr, ((float*)((unsigned char*)p.ws + WS_MODS)), 2, 256}); }
    else phase_normmod<1>(nullptr, nullptr, ((bf16_t*)((unsigned char*)p.ws + WS_X1)), ((bf16_t*)((unsigned char*)p.out + DO_H)), p.norm2_w, ((float*)((unsigned char*)p.ws + WS_MODS)), 3, 4, ML, 0, cvirt - 32, G - 32);
    GSYNC();
    phase_normmod<1>(nullptr, nullptr, ((bf16_t*)((unsigned char*)p.ws + WS_X1)), ((bf16_t*)((unsigned char*)p.out + DO_H)), p.norm2_w, ((float*)((unsigned char*)p.ws + WS_MODS)), 3, 4, MT, ML, bid, G);
    GSYNC();
    { S.init(MT, NMIX, G, cvirt); pg8::gemm_phase(lds, pg8::Gemm{((bf16_t*)((unsigned char*)p.out + DO_H)), ((bf16_t*)((unsigned char*)p.out + DO_WTMIX)), MT, NMIX, 1024}, S, EpiMix{((bf16_t*)((unsigned char*)p.ws + WS_QKV)), ((bf16_t*)((unsigned char*)p.out + DO_SIDE)), ((bf16_t*)((unsigned char*)p.ws + WS_GATE)), ((bf16_t*)((unsigned char*)p.ws + WS_POOL)), ((bf16_t*)((unsigned char*)p.ws + WS_MIXG)), ((float*)((unsigned char*)p.ws + WS_BG)), p.a_log, p.dt_bias}); }
    GSYNC();
    phase_conv(p, ((bf16_t*)((unsigned char*)p.ws + WS_QKV)), ((bf16_t*)((unsigned char*)p.out + DO_SIDE)), ((float*)((unsigned char*)p.ws + WS_BG)));
    GSYNC();
    phase_gdn(shm, ((bf16_t*)((unsigned char*)p.ws + WS_QKV)), ((float*)((unsigned char*)p.ws + WS_BG)), ((bf16_t*)((unsigned char*)p.out + DO_OF)), ((bf16_t*)((unsigned char*)p.out + DO_OB)));
    GSYNC();
    phase_pool(p, shm, ((bf16_t*)((unsigned char*)p.ws + WS_POOL)), ((bf16_t*)((unsigned char*)p.ws + WS_WTPOOLW)), ((bf16_t*)((unsigned char*)p.ws + WS_POOLPRE)));
    phase_onorm(p, ((bf16_t*)((unsigned char*)p.out + DO_OF)), ((bf16_t*)((unsigned char*)p.out + DO_OB)), ((bf16_t*)((unsigned char*)p.ws + WS_GATE)));
    GSYNC();
    { S.init(ML, 1024, G, cvirt); pg8::gemm_phase(lds, pg8::Gemm{((bf16_t*)((unsigned char*)p.ws + WS_POOLPRE)), ((bf16_t*)((unsigned char*)p.ws + WS_WTPOOL)), ML, 1024, 512}, S, EpiMerge<0>{((bf16_t*)((unsigned char*)p.ws + WS_MIXG)), nullptr, ((bf16_t*)((unsigned char*)p.ws + WS_T))}); }
    GSYNC();
    { S.init(ML, 1024, G, cvirt); pg8::gemm_phase(lds, pg8::Gemm{((bf16_t*)((unsigned char*)p.out + DO_OF)), ((bf16_t*)((unsigned char*)p.ws + WS_WTGDN)), ML, 1024, 1024}, S, EpiMerge<1>{((bf16_t*)((unsigned char*)p.ws + WS_MIXG)), ((bf16_t*)((unsigned char*)p.ws + WS_T)), ((bf16_t*)((unsigned char*)p.ws + WS_M))}); }
    GSYNC();
    { S.init(ML, 1024, G, cvirt); pg8::gemm_phase(lds, pg8::Gemm{((bf16_t*)((unsigned char*)p.ws + WS_M)), ((bf16_t*)((unsigned char*)p.ws + WS_WTMIXOUT)), ML, 1024, 1024}, S, EpiMixOut{((bf16_t*)((unsigned char*)p.ws + WS_X1)), p.out, ((float*)((unsigned char*)p.ws + WS_MODS))}); }
    GSYNC();
    phase_normmod<2>(p.out, nullptr, nullptr, ((bf16_t*)((unsigned char*)p.ws + WS_H3)), p.norm3_w, ((float*)((unsigned char*)p.ws + WS_MODS)), 6, 7, ML, 0, bid, G);
    GSYNC();
    { S.init(ML, 2 * DFF, G, cvirt); pg8::gemm_phase(lds, pg8::Gemm{((bf16_t*)((unsigned char*)p.ws + WS_H3)), ((bf16_t*)((unsigned char*)p.ws + WS_WTFFN2IN)), ML, 2 * DFF, 1024}, S, EpiFfnA{((bf16_t*)((unsigned char*)p.ws + WS_HID))}); }
    GSYNC();
    { S.init(ML, 1024, G, cvirt); pg8::gemm_phase(lds, pg8::Gemm{((bf16_t*)((unsigned char*)p.ws + WS_HID)), ((bf16_t*)((unsigned char*)p.ws + WS_WTFFN2OUT)), ML, 1024, DFF}, S, EpiFfnB<false>{nullptr, nullptr, nullptr, p.out, ((float*)((unsigned char*)p.ws + WS_MODS)), 8}); }
    GSYNC();
    phase_final_norm(p.out, p.final_norm_w);
}

extern "C" void kernel_launch(void* const* d_in, const int* in_sizes, int n_in, void* d_out, int out_size, void* d_ws, size_t ws_size, hipStream_t stream) {
    static int grid_blocks = 0;
    if (!grid_blocks) {
        hipFuncSetAttribute((const void*)fwd_megakernel, hipFuncAttributeMaxDynamicSharedMemorySize, (int)kDynLds);
        int dev = 0, cus = 0, per_cu = 0;
        hipGetDevice(&dev);
        hipDeviceGetAttribute(&cus, hipDeviceAttributeMultiprocessorCount, dev);
        hipOccupancyMaxActiveBlocksPerMultiprocessor(&per_cu, fwd_megakernel, 512, kDynLds);
        grid_blocks = cus * per_cu;
        if (grid_blocks > 256) grid_blocks = 256;
        if (grid_blocks <= 0) grid_blocks = 256;
    }
    if (ws_size < WS_TOTAL) { fprintf(stderr, "workspace too small: %zu < %zu\n", ws_size, (size_t)WS_TOTAL); return; }
    Params p{};
    const float** pp = (const float**)&p;
    for (int i = 0; i < 24; ++i) pp[i] = (const float*)d_in[i];
    p.out = (float*)d_out; p.ws = (unsigned char*)d_ws;
    (void)hipMemsetAsync((unsigned char*)d_ws + WS_BAR, 0, XCD_BAR_WORDS * 4, stream);
    void* args[] = {&p};
    hipError_t e = hipLaunchCooperativeKernel((void*)fwd_megakernel, dim3(grid_blocks), dim3(512), args, kDynLds, stream);
    if (e != hipSuccess) fprintf(stderr, "cooperative launch failed: %s (grid %d)\n", hipGetErrorString(e), grid_blocks);
}
```
